# Optimizing an MI355X kernel written in HIP

```python
import jax, jax.numpy as jnp
from jax import lax
import numpy as np

D_MODEL = 1024
BATCH = 8
SEQ = 4096
DEPTH = 4

N_META = 16
D_MIX = D_MODEL
LRU_WIDTH = D_MIX // 2
LRU_HEADS = 8
LRU_HEAD_DIM = LRU_WIDTH // LRU_HEADS
CONV_WIDTH = 4
LRU_C = 8.0
MLA_HEADS = 8
QK_NOPE = 64
QK_ROPE = 32
V_DIM = (D_MIX - LRU_WIDTH) // MLA_HEADS
Q_LORA = 3 * D_MODEL // 8
KV_LORA = D_MODEL // 4
IN_COLS = 2 * LRU_WIDTH + Q_LORA + KV_LORA + QK_ROPE
D_FF = 11 * D_MODEL // 4
ROPE_THETA = 10000.0
Q_BLOCK = 128
EPS = 1e-6

kernel_name = 'hymba_rglru_mla_macaron_sandwich'


def rms_norm(x, g):
    xf = x.astype(jnp.float32)
    y = xf * lax.rsqrt(jnp.mean(xf * xf, axis=-1, keepdims=True) + EPS)
    return (y * g.astype(jnp.float32)).astype(x.dtype)


def swiglu(u, w_gate, w_up, w_down):
    return (jax.nn.silu(u @ w_gate) * (u @ w_up)) @ w_down


def rope_tables(T):
    pos = jnp.arange(T, dtype=jnp.float32)
    inv_freq = 1.0 / (ROPE_THETA ** (jnp.arange(0, QK_ROPE, 2, dtype=jnp.float32) / QK_ROPE))
    ang = pos[:, None] * inv_freq[None, :]
    return jnp.cos(ang), jnp.sin(ang)


def apply_rope(x, cos, sin):
    x1, x2 = jnp.split(x, 2, axis=-1)
    cos = cos.astype(x.dtype)
    sin = sin.astype(x.dtype)
    return jnp.concatenate([x1 * cos - x2 * sin, x2 * cos + x1 * sin], axis=-1)


def _lru_combine(left, right):
    a_l, b_l = left
    a_r, b_r = right
    return a_l * a_r, a_r * b_l + b_r


def rglru_group(xr, gr, conv_w, conv_b, w_a, b_a, w_x, b_x, lam):
    B, T, W = xr.shape
    xp = jnp.pad(xr, ((0, 0), (CONV_WIDTH - 1, 0), (0, 0)))
    xc = xp[:, CONV_WIDTH - 1:] * conv_w[CONV_WIDTH - 1] + conv_b
    for k in range(CONV_WIDTH - 1):
        xc = xc + xp[:, k:k + T] * conv_w[k]
    xh = xc.reshape(B, T, LRU_HEADS, LRU_HEAD_DIM)
    r = jax.nn.sigmoid(jnp.einsum('bthi,hij->bthj', xh, w_a).reshape(B, T, W) + b_a)
    i = jax.nn.sigmoid(jnp.einsum('bthi,hij->bthj', xh, w_x).reshape(B, T, W) + b_x)
    log_a = -LRU_C * r.astype(jnp.float32) * jax.nn.softplus(-lam.astype(jnp.float32))
    a = jnp.exp(log_a)
    b = jnp.sqrt(-jnp.expm1(2.0 * log_a)) * (i * xc).astype(jnp.float32)
    _, h = lax.associative_scan(_lru_combine, (a, b), axis=1)
    return h.astype(xr.dtype) * jax.nn.gelu(gr)


def causal_block_attention(q, k, v):
    B, T, H, Dqk = q.shape
    n_blk = -(-T // Q_BLOCK)
    pad = n_blk * Q_BLOCK - T
    qb = jnp.pad(q, ((0, 0), (0, pad), (0, 0), (0, 0)))
    qb = qb.reshape(B, n_blk, Q_BLOCK, H, Dqk).transpose(1, 0, 2, 3, 4)
    scale = Dqk ** -0.5
    kpos = jnp.arange(T)

    def one_block(args):
        q_blk, blk = args
        s = jnp.einsum('bqhd,bkhd->bhqk', q_blk, k).astype(jnp.float32) * scale
        qpos = blk * Q_BLOCK + jnp.arange(Q_BLOCK)
        s = jnp.where(kpos[None, :] <= qpos[:, None], s, -jnp.inf)
        p = jax.nn.softmax(s, axis=-1).astype(v.dtype)
        return jnp.einsum('bhqk,bkhd->bqhd', p, v)

    o = lax.map(one_block, (qb, jnp.arange(n_blk)))
    o = o.transpose(1, 0, 2, 3, 4).reshape(B, n_blk * Q_BLOCK, H, v.shape[-1])
    return o[:, :T]


def mla_group(cq, ckv, kr, cos, sin, q_norm_g, w_uq, kv_norm_g, w_ukv):
    B, T, _ = cq.shape
    q = (rms_norm(cq, q_norm_g) @ w_uq).reshape(B, T, MLA_HEADS, QK_NOPE + QK_ROPE)
    q_nope, q_rope = jnp.split(q, [QK_NOPE], axis=-1)
    q_rope = apply_rope(q_rope, cos[None, :, None, :], sin[None, :, None, :])
    kv = (rms_norm(ckv, kv_norm_g) @ w_ukv).reshape(B, T, MLA_HEADS, QK_NOPE + V_DIM)
    k_nope, v = jnp.split(kv, [QK_NOPE], axis=-1)
    k_rope = apply_rope(kr, cos[None], sin[None])
    k_rope = jnp.broadcast_to(k_rope[:, :, None, :], (B, T, MLA_HEADS, QK_ROPE))
    qf = jnp.concatenate([q_nope, q_rope], axis=-1)
    kf = jnp.concatenate([k_nope, k_rope], axis=-1)
    return causal_block_attention(qf, kf, v).reshape(B, T, MLA_HEADS * V_DIM)


def setup_inputs(seed: int = 0) -> dict:
    key = jax.random.key(seed)
    ks = jax.random.split(key, 32)

    def nrm(k, shape, scale):
        return jax.random.normal(k, shape, jnp.float32) * scale

    def gain(k, n):
        return 1.0 + 0.02 * jax.random.normal(k, (DEPTH, n), jnp.float32)

    a0 = jax.random.uniform(ks[15], (DEPTH, LRU_WIDTH), jnp.float32, 0.9, 0.999)
    lam = jnp.log(a0) - jnp.log1p(-a0)
    return {
        'x': nrm(ks[0], (BATCH, SEQ, D_MODEL), 1.0),
        'meta_tokens': nrm(ks[1], (N_META, D_MODEL), 1.0),
        'ffn1_pre_g': gain(ks[2], D_MODEL),
        'ffn1_w_gate': nrm(ks[3], (DEPTH, D_MODEL, D_FF), D_MODEL ** -0.5),
        'ffn1_w_up': nrm(ks[4], (DEPTH, D_MODEL, D_FF), D_MODEL ** -0.5),
        'ffn1_w_down': nrm(ks[5], (DEPTH, D_FF, D_MODEL), D_FF ** -0.5),
        'ffn1_post_g': gain(ks[6], D_MODEL),
        'mix_pre_g': gain(ks[7], D_MODEL),
        'w_in': nrm(ks[8], (DEPTH, D_MODEL, IN_COLS), D_MODEL ** -0.5),
        'lru_conv_w': nrm(ks[9], (DEPTH, CONV_WIDTH, LRU_WIDTH), CONV_WIDTH ** -0.5),
        'lru_conv_b': nrm(ks[10], (DEPTH, LRU_WIDTH), 0.01),
        'lru_w_a': nrm(ks[11], (DEPTH, LRU_HEADS, LRU_HEAD_DIM, LRU_HEAD_DIM), LRU_HEAD_DIM ** -0.5),
        'lru_b_a': nrm(ks[12], (DEPTH, LRU_WIDTH), 0.01),
        'lru_w_x': nrm(ks[13], (DEPTH, LRU_HEADS, LRU_HEAD_DIM, LRU_HEAD_DIM), LRU_HEAD_DIM ** -0.5),
        'lru_b_x': nrm(ks[14], (DEPTH, LRU_WIDTH), 0.01),
        'lru_lambda': lam,
        'mla_q_norm_g': gain(ks[16], Q_LORA),
        'mla_w_uq': nrm(ks[17], (DEPTH, Q_LORA, MLA_HEADS * (QK_NOPE + QK_ROPE)), Q_LORA ** -0.5),
        'mla_kv_norm_g': gain(ks[18], KV_LORA),
        'mla_w_ukv': nrm(ks[19], (DEPTH, KV_LORA, MLA_HEADS * (QK_NOPE + V_DIM)), KV_LORA ** -0.5),
        'lru_out_g': gain(ks[20], LRU_WIDTH),
        'mla_out_g': gain(ks[21], MLA_HEADS * V_DIM),
        'w_out': nrm(ks[22], (DEPTH, D_MIX, D_MODEL), D_MIX ** -0.5),
        'mix_post_g': gain(ks[23], D_MODEL),
        'ffn2_pre_g': gain(ks[24], D_MODEL),
        'ffn2_w_gate': nrm(ks[25], (DEPTH, D_MODEL, D_FF), D_MODEL ** -0.5),
        'ffn2_w_up': nrm(ks[26], (DEPTH, D_MODEL, D_FF), D_MODEL ** -0.5),
        'ffn2_w_down': nrm(ks[27], (DEPTH, D_FF, D_MODEL), D_FF ** -0.5),
        'ffn2_post_g': gain(ks[28], D_MODEL),
    }


def reference(x, meta_tokens, ffn1_pre_g, ffn1_w_gate, ffn1_w_up, ffn1_w_down, ffn1_post_g,
              mix_pre_g, w_in, lru_conv_w, lru_conv_b, lru_w_a, lru_b_a, lru_w_x, lru_b_x,
              lru_lambda, mla_q_norm_g, mla_w_uq, mla_kv_norm_g, mla_w_ukv, lru_out_g,
              mla_out_g, w_out, mix_post_g, ffn2_pre_g, ffn2_w_gate, ffn2_w_up, ffn2_w_down,
              ffn2_post_g):
    B = x.shape[0]
    meta = jnp.broadcast_to(meta_tokens.astype(x.dtype)[None], (B, N_META, D_MODEL))
    h = jnp.concatenate([meta, x], axis=1)
    T = h.shape[1]
    cos, sin = rope_tables(T)
    splits = [LRU_WIDTH, 2 * LRU_WIDTH, 2 * LRU_WIDTH + Q_LORA, 2 * LRU_WIDTH + Q_LORA + KV_LORA]
    for l in range(DEPTH):
        f = swiglu(rms_norm(h, ffn1_pre_g[l]), ffn1_w_gate[l], ffn1_w_up[l], ffn1_w_down[l])
        h = h + 0.5 * rms_norm(f, ffn1_post_g[l])
        z = rms_norm(h, mix_pre_g[l]) @ w_in[l]
        xr, gr, cq, ckv, kr = jnp.split(z, splits, axis=-1)
        y_lru = rglru_group(xr, gr, lru_conv_w[l], lru_conv_b[l], lru_w_a[l], lru_b_a[l],
                            lru_w_x[l], lru_b_x[l], lru_lambda[l])
        y_mla = mla_group(cq, ckv, kr, cos, sin, mla_q_norm_g[l], mla_w_uq[l],
                          mla_kv_norm_g[l], mla_w_ukv[l])
        y = jnp.concatenate([rms_norm(y_lru, lru_out_g[l]), rms_norm(y_mla, mla_out_g[l])],
                            axis=-1) @ w_out[l]
        h = h + rms_norm(y, mix_post_g[l])
        f = swiglu(rms_norm(h, ffn2_pre_g[l]), ffn2_w_gate[l], ffn2_w_up[l], ffn2_w_down[l])
        h = h + 0.5 * rms_norm(f, ffn2_post_g[l])
    return h[:, N_META:]
```

```cpp
#include <hip/hip_runtime.h>
#include <hip/hip_cooperative_groups.h>
#include <cstdio>
#include <cstdint>
#include <cmath>
namespace cg = cooperative_groups;

#define DI __device__ __forceinline__
#define LAS __attribute__((address_space(3)))
typedef unsigned short bf16_t;
typedef short bf16x8 __attribute__((ext_vector_type(8)));
typedef float f32x4 __attribute__((ext_vector_type(4)));
typedef float f32x16 __attribute__((ext_vector_type(16)));
typedef unsigned u32x4 __attribute__((ext_vector_type(4)));
typedef unsigned u32x2 __attribute__((ext_vector_type(2)));
typedef float f32x2_t __attribute__((ext_vector_type(2)));
typedef __bf16 bf16x2_t __attribute__((ext_vector_type(2)));

constexpr int NB = 8, SEQ = 4096, NMETA = 16, T = 4112, TP = 4160, D = 1024, M = NB * T, MP = 33024;
constexpr int DFF = 2816, NGU = 2 * DFF, LRUW = 512, QL = 384, KVL = 256, LDZ = 1664, NIN = 1792;
constexpr int NH = 8, DQK = 96, DV = 64, NQ = 768, NKV = 1024, NCH = 129, DEPTH = 4;
constexpr float EPS = 1e-6f;
constexpr float QSCALE = 0.10206207261596575f * 1.4426950408889634f;

constexpr size_t MiB = 1u << 20;
constexpr size_t WS_RSH = 0, WS_COS = 256 * 1024, WS_SIN = 768 * 1024;
constexpr size_t WS_SSQM = 1 * MiB + 256 * 1024;
constexpr size_t WS_SSQP = 2 * MiB + 512 * 1024;
constexpr size_t WS_AAGG = 5 * MiB + 256 * 1024, WS_BAGG = 7 * MiB + 512 * 1024;
constexpr size_t WS_BAR = 9 * MiB + 896 * 1024;
constexpr size_t WS_H = 10 * MiB;
constexpr size_t WS_HB = 139 * MiB;
constexpr size_t WS_FY = 203 * MiB + 512 * 1024;
constexpr size_t WS_W = 268 * MiB;
constexpr size_t WS_ACT = 308 * MiB;
constexpr size_t WS_Z = 308 * MiB;
constexpr size_t WS_VT = 413 * MiB;
constexpr size_t WS_AOUT = 446 * MiB;
constexpr size_t WS_END = 512 * MiB;
constexpr size_t WS_PARTD = 490 * MiB;
constexpr size_t WS_PARTO = WS_Z;
constexpr size_t WS_K = WS_H + 65 * MiB, WS_Q = WS_FY;
constexpr size_t KiB = 1024;
constexpr size_t WO_GU1 = 0, WO_D1 = 11 * MiB, WO_IN = 16 * MiB + 512 * KiB, WO_UQ = 20 * MiB, WO_UKV = 20 * MiB + 640 * KiB, WO_OUT = 21 * MiB + 256 * KiB,
                 WO_GU2 = 23 * MiB + 256 * KiB, WO_D2 = 34 * MiB + 256 * KiB, WO_LRU = 39 * MiB + 768 * KiB;
static_assert(WO_LRU + 128 * KiB <= 40 * MiB, "weights fit");
constexpr size_t DO_HLOC = 0, DO_PA = 33 * MiB, DO_KR = 66 * MiB;

constexpr int LDS_BYTES = 135168;

DI int opq_s() { int z; asm volatile("s_mov_b32 %0, 0" : "=s"(z)); return z; }
DI int opq_tid() { int t = threadIdx.x; asm volatile("" : "+v"(t)); return t; }
DI float opq_zf() { float z; asm volatile("v_mov_b32 %0, 0" : "=v"(z)); return z; }
#define GAS __attribute__((address_space(1)))
template <class T> DI T* launder_g(T* p) { GAS T* g = (GAS T*)p; asm volatile("" : "+s"(g)); return (T*)g; }
DI float bf2f(bf16_t v) { return __uint_as_float(((unsigned)v) << 16); }
DI unsigned cvt_pk(float lo, float hi) { f32x2_t v = {lo, hi}; bf16x2_t b = __builtin_convertvector(v, bf16x2_t); return __builtin_bit_cast(unsigned, b); }
DI bf16_t f2bf(float x) { return (bf16_t)(cvt_pk(x, 0.f) & 0xffffu); }
DI float bflo(unsigned w) { return __uint_as_float(w << 16); }
DI float bfhi(unsigned w) { return __uint_as_float(w & 0xffff0000u); }
template <int K> DI float sx(float v) { static_assert(K >= 1 && K < 32, "xor mask"); return __int_as_float(__builtin_amdgcn_ds_swizzle(__float_as_int(v), (K << 10) | 0x1f)); }
DI float sum_x32(float v) { auto rr = __builtin_amdgcn_permlane32_swap(__float_as_uint(v), __float_as_uint(v), false, false); return __uint_as_float(rr[0]) + __uint_as_float(rr[1]); }
DI float max_x32(float v) { auto rr = __builtin_amdgcn_permlane32_swap(__float_as_uint(v), __float_as_uint(v), false, false); return fmaxf(__uint_as_float(rr[0]), __uint_as_float(rr[1])); }
DI float other_x32(float v, int hh) { auto rr = __builtin_amdgcn_permlane32_swap(__float_as_uint(v), __float_as_uint(v), false, false); return __uint_as_float(hh ? rr[0] : rr[1]); }
template <int CTRL> DI float dppx(float v) { return __int_as_float(__builtin_amdgcn_mov_dpp(__float_as_int(v), CTRL, 0xf, 0xf, true)); }
DI float wave_sum(float v) { v += dppx<0xB1>(v); v += dppx<0x4E>(v); v += dppx<0x124>(v); v += dppx<0x128>(v); v += sx<16>(v); return sum_x32(v); }
DI float sigmoidf_(float x) { return __builtin_amdgcn_rcpf(1.0f + __expf(-x)); }
DI float silu_(float x) { return x * __builtin_amdgcn_rcpf(1.0f + __expf(-x)); }
DI float gelu_tanh(float x) { const float u = 0.7978845608028654f * (x + 0.044715f * x * x * x); const float th = 1.0f - 2.0f * __builtin_amdgcn_rcpf(__expf(2.0f * u) + 1.0f); return 0.5f * x * (1.0f + th); }
DI int crow(int r, int hi) { return (r & 3) + 8 * (r >> 2) + 4 * hi; }
DI int vpos(int t) { return (t & ~12) | ((t & 4) << 1) | ((t & 8) >> 1); }
DI u32x4 pack8(f32x4 a, f32x4 b) { u32x4 w; w.x = cvt_pk(a[0], a[1]); w.y = cvt_pk(a[2], a[3]); w.z = cvt_pk(b[0], b[1]); w.w = cvt_pk(b[2], b[3]); return w; }

namespace pg8 {
constexpr int BM = 256, BK = 64, HALF = 128, HTB = HALF * BK * 2, STAGE_BYTES = 8 * HTB, NXCD = 8, WGM = 4;
DI int lds_byte(int r, int c) { const int st = (r >> 4) * 2 + (c >> 5), rr = r & 15, cc = c & 31, ob = rr * 64 + cc * 2; return st * 1024 + (ob ^ (((ob >> 9) & 1) << 5)); }
DI void stage_rc(int b, int& R, int& C) { const int st = b / 1024, sb = b % 1024, swz = sb ^ (((sb >> 9) & 1) << 5); R = (st >> 1) * 16 + swz / 64; C = (st & 1) * 32 + (swz % 64) / 2; }
DI int perm32(int rho) { const int n = rho >> 4, i = rho & 15; return 8 * (i >> 2) + 4 * n + (i & 3); }
struct Unit { int pm, pn; };
struct Gemm { const bf16_t* A; const bf16_t* Bt; int M, N, K, lda, ldb, row0; };
struct StaticOrder {
    int nM, nN, nwg, G, c;
    DI void init(int M_, int N_, int G_, int c_) { nM = M_ / BM; nN = N_ / BM; nwg = nM * nN; G = G_; c = c_; }
    DI bool next(int i, Unit& u) const {
        const long L = (long)i * G + c; if (L >= nwg) return false;
        int wgid = (int)L; { const int q = nwg / NXCD, r = nwg % NXCD, xcd = wgid % NXCD, off = wgid / NXCD; wgid = (xcd < r ? xcd * (q + 1) : r * (q + 1) + (xcd - r) * q) + off; }
        const int nig = WGM * nN, gid = wgid / nig, fm = gid * WGM, gsz = (nM - fm) < WGM ? (nM - fm) : WGM;
        u.pm = fm + ((wgid % nig) % gsz); u.pn = (wgid % nig) / gsz; return true;
    }
};
template <class Epi, class Sched>
DI void gemm_phase(LAS unsigned char* lds, const Gemm g, const Sched& S, const Epi& E) {
    const int tid = opq_tid(), wid = __builtin_amdgcn_readfirstlane(tid >> 6), lane = tid & 63, wr = wid >> 2, wc = wid & 3, fr = lane & 15, fq = lane >> 4;
    int K = g.K; asm volatile("" : "+s"(K));
    const int nt = K / BK;
    unsigned voffA[2], voffB[2];
#pragma unroll
    for (int i = 0; i < 2; ++i) { int R, C; stage_rc(tid * 16 + i * 8192, R, C); const int Rb = (R & ~31) + perm32(R & 31);
        voffA[i] = (unsigned)(R * g.lda + C) * 2u; voffB[i] = (unsigned)(Rb * g.ldb + C) * 2u; }
    const size_t kstep = (size_t)(BK * 2);
    const size_t hstepA = (size_t)HALF * g.lda * 2, hstepB = (size_t)HALF * g.ldb * 2;
    const size_t tstepA = 2 * hstepA, tstepB = 2 * hstepB;
    const unsigned ldsw = (unsigned)wid * 1024u;
    const int aoff = lds_byte(wr * 64 + fr, fq * 8), boff = lds_byte(wc * 32 + fr, fq * 8);
#define PG8_SA(b, h) (((b) * 2 + (h)) * HTB)
#define PG8_SB(b, h) ((4 + (b) * 2 + (h)) * HTB)
#define PG8_STAGE(bufoff, gbase, voff) do { _Pragma("unroll") for (int _i = 0; _i < 2; ++_i) \
        __builtin_amdgcn_global_load_lds((const unsigned*)((const char*)(gbase) + (voff)[_i]), (LAS unsigned*)(lds + (bufoff) + ldsw + _i * 8192), 16, 0, 0); } while (0)
#define PG8_LDA(dst, b, h) do { _Pragma("unroll") for (int m = 0; m < 4; ++m) _Pragma("unroll") for (int k = 0; k < 2; ++k) dst[m][k] = *(const LAS bf16x8*)(lds + PG8_SA(b, h) + aoff + m * 2048 + k * 1024); } while (0)
#define PG8_LDB(dst, b, h) do { _Pragma("unroll") for (int n = 0; n < 2; ++n) _Pragma("unroll") for (int k = 0; k < 2; ++k) dst[n][k] = *(const LAS bf16x8*)(lds + PG8_SB(b, h) + boff + n * 2048 + k * 1024); } while (0)
#define PG8_MMA(ai, bj, At, Bt) do { __builtin_amdgcn_s_setprio(1); _Pragma("unroll") for (int m = 0; m < 4; ++m) _Pragma("unroll") for (int n = 0; n < 2; ++n) _Pragma("unroll") for (int k = 0; k < 2; ++k) \
        acc[ai][bj][m][n] = __builtin_amdgcn_mfma_f32_16x16x32_bf16(Bt[n][k], At[m][k], acc[ai][bj][m][n], 0, 0, 0); __builtin_amdgcn_s_setprio(0); } while (0)
#define PG8_WAIT_V(n) asm volatile("s_waitcnt vmcnt(" #n ")" ::: "memory")
#define PG8_WAIT_L(n) asm volatile("s_waitcnt lgkmcnt(" #n ")" ::: "memory")
#define PG8_BAR __builtin_amdgcn_s_barrier()
#define PG8_SCHED __builtin_amdgcn_sched_barrier(0)
    Unit cur, nxt; int ui = 0;
    if (!S.next(0, cur)) return;
    f32x4 acc[2][2][4][2];
#pragma unroll
    for (int a = 0; a < 2; ++a)
#pragma unroll
        for (int b = 0; b < 2; ++b)
#pragma unroll
            for (int m = 0; m < 4; ++m)
#pragma unroll
                for (int n = 0; n < 2; ++n) acc[a][b][m][n] = (f32x4){0.f, 0.f, 0.f, 0.f};
    bf16x8 At[4][2], B0[2][2], B1[2][2];
    const char* cA = (const char*)g.A + (size_t)cur.pm * tstepA; const char* cB = (const char*)g.Bt + (size_t)cur.pn * tstepB;
    PG8_STAGE(PG8_SB(0, 0), cB, voffB); PG8_STAGE(PG8_SB(0, 1), cB + hstepB, voffB); PG8_STAGE(PG8_SA(0, 0), cA, voffA); PG8_STAGE(PG8_SA(0, 1), cA + hstepA, voffA);
    if (wr == 1) PG8_BAR;
    PG8_WAIT_V(2); PG8_BAR;
    PG8_STAGE(PG8_SB(1, 0), cB + kstep, voffB); PG8_STAGE(PG8_SA(1, 0), cA + kstep, voffA); PG8_STAGE(PG8_SB(1, 1), cB + hstepB + kstep, voffB);
    PG8_WAIT_V(6); PG8_BAR;
    for (;;) {
        const bool has_next = S.next(ui + 1, nxt);
        const char* nA = has_next ? (const char*)g.A + (size_t)nxt.pm * tstepA : cA; const char* nB = has_next ? (const char*)g.Bt + (size_t)nxt.pn * tstepB : cB;
        const bool full = (g.row0 + cur.pm * BM + HALF) < 32896;
        for (int t = 0; t < nt; t += 2) {
            const bool last = (t == nt - 2);
            if constexpr (Epi::MIDSCALE) { if (t == (nt >> 1)) { int wr_ = wr, wc_ = wc, fr_ = fr, fq_ = fq; asm volatile("" : "+s"(wr_), "+s"(wc_), "+v"(fr_), "+v"(fq_)); E.midscale(acc, cur, wr_, wc_, fr_, fq_); } }
            const char* a1 = cA + (size_t)(t + 1) * kstep;
            const char* a2 = last ? nA : cA + (size_t)(t + 2) * kstep; const char* b2 = last ? nB : cB + (size_t)(t + 2) * kstep;
            const char* a3 = a2 + kstep; const char* b3 = b2 + kstep;
            PG8_LDB(B0, 0, 0); PG8_LDB(B1, 0, 1); PG8_SCHED; PG8_LDA(At, 0, 0); PG8_STAGE(PG8_SA(1, 1), a1 + hstepA, voffA);
            PG8_WAIT_V(8); PG8_WAIT_L(0); PG8_BAR; PG8_MMA(0, 0, At, B0); PG8_MMA(0, 1, At, B1); PG8_BAR; PG8_SCHED;
            PG8_LDA(At, 0, 1); PG8_STAGE(PG8_SB(0, 0), b2, voffB); PG8_STAGE(PG8_SB(0, 1), b2 + hstepB, voffB); PG8_STAGE(PG8_SA(0, 0), a2, voffA);
            PG8_WAIT_V(8); PG8_WAIT_L(0); PG8_BAR; if (full) { PG8_MMA(1, 0, At, B0); PG8_MMA(1, 1, At, B1); } PG8_BAR; PG8_SCHED;
            PG8_LDB(B0, 1, 0); PG8_LDB(B1, 1, 1); PG8_SCHED; PG8_LDA(At, 1, 0); PG8_STAGE(PG8_SA(0, 1), a2 + hstepA, voffA);
            PG8_WAIT_V(8); PG8_WAIT_L(0); PG8_BAR; PG8_MMA(0, 0, At, B0); PG8_MMA(0, 1, At, B1); PG8_BAR; PG8_SCHED;
            PG8_LDA(At, 1, 1); PG8_STAGE(PG8_SB(1, 0), b3, voffB); PG8_STAGE(PG8_SB(1, 1), b3 + hstepB, voffB); PG8_STAGE(PG8_SA(1, 0), a3, voffA);
            PG8_WAIT_V(8); PG8_WAIT_L(0); PG8_BAR; if (full) { PG8_MMA(1, 0, At, B0); PG8_MMA(1, 1, At, B1); } PG8_BAR; PG8_SCHED;
        }
        if (wr == 0) PG8_BAR;
        { int wr_ = wr, wc_ = wc, fr_ = fr, fq_ = fq; asm volatile("" : "+s"(wr_), "+s"(wc_), "+v"(fr_), "+v"(fq_)); E(acc, cur, wr_, wc_, fr_, fq_); }
        if (!has_next) break;
#pragma unroll
        for (int a = 0; a < 2; ++a)
#pragma unroll
            for (int b = 0; b < 2; ++b)
#pragma unroll
                for (int m = 0; m < 4; ++m)
#pragma unroll
                    for (int n = 0; n < 2; ++n) acc[a][b][m][n] = (f32x4){0.f, 0.f, 0.f, 0.f};
        cur = nxt; cA = nA; cB = nB; ++ui;
        if (wr == 1) PG8_BAR;
    }
    PG8_WAIT_V(0);
    PG8_BAR;
#undef PG8_SA
#undef PG8_SB
#undef PG8_STAGE
#undef PG8_LDA
#undef PG8_LDB
#undef PG8_MMA
#undef PG8_WAIT_V
#undef PG8_WAIT_L
#undef PG8_BAR
#undef PG8_SCHED
}
}
using pg8::Unit;
typedef f32x4 Acc[2][2][4][2];

struct EpiGU {
    static constexpr bool MIDSCALE = false;
    unsigned char* ws;
    DI void midscale(Acc&, const Unit&, int, int, int, int) const {}
    DI void operator()(const Acc& acc, const Unit& u, int wr, int wc, int fr, int fq) const {
        unsigned char* w = launder_g(ws);
        bf16_t* O = (bf16_t*)(w + WS_ACT); const float* rs = (const float*)(w + WS_RSH);
#pragma unroll
        for (int ai = 0; ai < 2; ++ai)
#pragma unroll
            for (int m = 0; m < 4; ++m) {
                const int row = u.pm * 256 + ai * 128 + wr * 64 + m * 16 + fr;
                const float s = rs[row];
                f32x4 o0, o1;
#pragma unroll
                for (int j = 0; j < 4; ++j) { o0[j] = silu_(acc[ai][0][m][0][j] * s) * (acc[ai][1][m][0][j] * s); o1[j] = silu_(acc[ai][0][m][1][j] * s) * (acc[ai][1][m][1][j] * s); }
                *(u32x4*)(O + (size_t)row * DFF + u.pn * 128 + wc * 32 + 8 * fq) = pack8(o0, o1);
            }
    }
};
template <bool MID> struct EpiStore {
    static constexpr bool MIDSCALE = MID;
    unsigned char* ws;
    DI void midscale(Acc& acc, const Unit& u, int wr, int wc, int fr, int fq) const {
        unsigned char* w = launder_g(ws);
        const float* ssq = (const float*)(w + WS_SSQM);
#pragma unroll
        for (int ai = 0; ai < 2; ++ai)
#pragma unroll
            for (int m = 0; m < 4; ++m) {
                const int row = u.pm * 256 + ai * 128 + wr * 64 + m * 16 + fr;
                const f32x4 sa = *(const f32x4*)(ssq + (size_t)row * 8), sb = *(const f32x4*)(ssq + (size_t)row * 8 + 4);
                const float s = rsqrtf((((sa[0] + sa[1]) + (sa[2] + sa[3])) + ((sb[0] + sb[1]) + (sb[2] + sb[3]))) * (1.0f / 512.0f) + EPS);
#pragma unroll
                for (int bj = 0; bj < 2; ++bj)
#pragma unroll
                    for (int n = 0; n < 2; ++n) acc[ai][bj][m][n] = acc[ai][bj][m][n] * s;
            }
    }
    DI void operator()(const Acc& acc, const Unit& u, int wr, int wc, int fr, int fq) const {
        unsigned char* w = launder_g(ws);
        bf16_t* O = (bf16_t*)(w + WS_FY);
#pragma unroll
        for (int ai = 0; ai < 2; ++ai)
#pragma unroll
            for (int m = 0; m < 4; ++m) {
                const int row = u.pm * 256 + ai * 128 + wr * 64 + m * 16 + fr;
#pragma unroll
                for (int bj = 0; bj < 2; ++bj)
                    *(u32x4*)(O + (size_t)row * D + u.pn * 256 + bj * 128 + wc * 32 + 8 * fq) = pack8(acc[ai][bj][m][0], acc[ai][bj][m][1]);
            }
    }
};
struct EpiPart {
    static constexpr bool MIDSCALE = false;
    unsigned char* ws; float* part; int scale_mla;
    DI void midscale(Acc&, const Unit&, int, int, int, int) const {}
    DI void operator()(const Acc& acc, const Unit& u, int wr, int wc, int fr, int fq) const {
        unsigned char* w = launder_g(ws); float* pp = launder_g(part);
        const float* ssq = (const float*)(w + WS_SSQM);
#pragma unroll
        for (int m = 0; m < 4; ++m) {
            const int rl = wr * 64 + m * 16 + fr;
            float s = 1.0f;
            if (scale_mla) { const size_t row = 32768 + rl; const f32x4 sa = *(const f32x4*)(ssq + row * 8), sb = *(const f32x4*)(ssq + row * 8 + 4);
                s = rsqrtf((((sa[0] + sa[1]) + (sa[2] + sa[3])) + ((sb[0] + sb[1]) + (sb[2] + sb[3]))) * (1.0f / 512.0f) + EPS); }
#pragma unroll
            for (int bj = 0; bj < 2; ++bj) {
                float* d = pp + (size_t)rl * D + u.pn * 256 + bj * 128 + wc * 32 + 8 * fq;
                *(f32x4*)d = acc[0][bj][m][0] * s; *(f32x4*)(d + 4) = acc[0][bj][m][1] * s;
            }
        }
    }
};
struct EpiIn {
    static constexpr bool MIDSCALE = false;
    unsigned char* ws; unsigned char* dout;
    DI void midscale(Acc&, const Unit&, int, int, int, int) const {}
    DI void operator()(const Acc& acc, const Unit& u, int wr, int wc, int fr, int fq) const {
        unsigned char* w = launder_g(ws); unsigned char* dq = launder_g(dout);
        bf16_t* Z = (bf16_t*)(w + WS_Z); bf16_t* KR = (bf16_t*)(dq + DO_KR); const float* rs = (const float*)(w + WS_RSH);
        float* ssqp = (float*)(w + WS_SSQP); const float* cosT = (const float*)(w + WS_COS); const float* sinT = (const float*)(w + WS_SIN);
#pragma unroll
        for (int ai = 0; ai < 2; ++ai)
#pragma unroll
            for (int m = 0; m < 4; ++m) {
                const int row = u.pm * 256 + ai * 128 + wr * 64 + m * 16 + fr;
                const float s = rs[row];
#pragma unroll
                for (int bj = 0; bj < 2; ++bj) {
                    const int cb = u.pn * 256 + bj * 128 + wc * 32;
                    const int col = cb + 8 * fq;
                    const f32x4 v0 = acc[ai][bj][m][0] * s, v1 = acc[ai][bj][m][1] * s;
                    if (cb < LDZ) {
                        *(u32x4*)(Z + (size_t)row * LDZ + col) = pack8(v0, v1);
                        if (cb >= 1024) {
                            float q = (v0[0] * v0[0] + v0[1] * v0[1]) + (v0[2] * v0[2] + v0[3] * v0[3]) + (v1[0] * v1[0] + v1[1] * v1[1]) + (v1[2] * v1[2] + v1[3] * v1[3]);
                            q += sx<16>(q); q = sum_x32(q);
                            if (fq == 0 && row < M) ssqp[(size_t)row * 20 + ((cb - 1024) >> 5)] = q;
                        }
                    } else if (cb == LDZ) {
                        if (row < M) {
                            const int t = row % T;
                            const f32x4 c = *(const f32x4*)(cosT + t * 16 + 4 * fq), sn = *(const f32x4*)(sinT + t * 16 + 4 * fq);
                            const f32x4 o1 = v0 * c - v1 * sn, o2 = v1 * c + v0 * sn;
                            *(u32x4*)(KR + (size_t)row * 32 + 8 * fq) = pack8(o1, o2);
                        }
                    }
                }
            }
    }
};
struct EpiQ {
    static constexpr bool MIDSCALE = false;
    unsigned char* ws;
    DI void midscale(Acc&, const Unit&, int, int, int, int) const {}
    DI void operator()(const Acc& acc, const Unit& u, int wr, int wc, int fr, int fq) const {
        unsigned char* w = launder_g(ws);
        bf16_t* Q = (bf16_t*)(w + WS_Q); const float* ssqp = (const float*)(w + WS_SSQP); const float* cosT = (const float*)(w + WS_COS); const float* sinT = (const float*)(w + WS_SIN);
#pragma unroll
        for (int ai = 0; ai < 2; ++ai)
#pragma unroll
            for (int m = 0; m < 4; ++m) {
                const int row = u.pm * 256 + ai * 128 + wr * 64 + m * 16 + fr;
                if (row < M) {
                    const int b = row / T, t = row - b * T;
                    const f32x4 sa = *(const f32x4*)(ssqp + (size_t)row * 20), sb = *(const f32x4*)(ssqp + (size_t)row * 20 + 4), sc = *(const f32x4*)(ssqp + (size_t)row * 20 + 8);
                    const float ssq = ((sa[0] + sa[1]) + (sa[2] + sa[3])) + ((sb[0] + sb[1]) + (sb[2] + sb[3])) + ((sc[0] + sc[1]) + (sc[2] + sc[3]));
                    const float s = rsqrtf(ssq * (1.0f / 384.0f) + EPS) * QSCALE;
#pragma unroll
                    for (int bj = 0; bj < 2; ++bj) {
                        const int col = u.pn * 256 + bj * 128 + wc * 32 + 8 * fq;
                        const int hd = col / 96, dd = col - hd * 96;
                        f32x4 v0 = acc[ai][bj][m][0] * s, v1 = acc[ai][bj][m][1] * s;
                        if (dd >= 64) {
                            const int g = (dd - 64) >> 3;
                            const f32x4 c = *(const f32x4*)(cosT + t * 16 + 4 * g), sn = *(const f32x4*)(sinT + t * 16 + 4 * g);
                            const f32x4 o1 = v0 * c - v1 * sn, o2 = v1 * c + v0 * sn; v0 = o1; v1 = o2;
                        }
                        *(u32x4*)(Q + ((size_t)(b * NH + hd) * TP + t) * DQK + dd) = pack8(v0, v1);
                    }
                }
            }
    }
};
struct EpiKV {
    static constexpr bool MIDSCALE = false;
    unsigned char* ws; unsigned char* dout;
    DI void midscale(Acc&, const Unit&, int, int, int, int) const {}
    DI void operator()(const Acc& acc, const Unit& u, int wr, int wc, int fr, int fq) const {
        unsigned char* w = launder_g(ws); unsigned char* dq = launder_g(dout);
        bf16_t* Kb = (bf16_t*)(w + WS_K); bf16_t* Vt = (bf16_t*)(w + WS_VT); const bf16_t* KR = (const bf16_t*)(dq + DO_KR); const float* ssqp = (const float*)(w + WS_SSQP);
#pragma unroll
        for (int ai = 0; ai < 2; ++ai)
#pragma unroll
            for (int m = 0; m < 4; ++m) {
                const int row = u.pm * 256 + ai * 128 + wr * 64 + m * 16 + fr;
                if (row < M) {
                    const int b = row / T, t = row - b * T;
                    const f32x4 sa = *(const f32x4*)(ssqp + (size_t)row * 20 + 12), sb = *(const f32x4*)(ssqp + (size_t)row * 20 + 16);
                    const float ssq = ((sa[0] + sa[1]) + (sa[2] + sa[3])) + ((sb[0] + sb[1]) + (sb[2] + sb[3]));
                    const float s = rsqrtf(ssq * (1.0f / 256.0f) + EPS);
#pragma unroll
                    for (int bj = 0; bj < 2; ++bj) {
                        const int hd = u.pn * 2 + bj;
                        const f32x4 v0 = acc[ai][bj][m][0] * s, v1 = acc[ai][bj][m][1] * s;
                        bf16_t* krow = Kb + ((size_t)(b * NH + hd) * TP + t) * DQK;
                        if (wc < 2) {
                            *(u32x4*)(krow + wc * 32 + 8 * fq) = pack8(v0, v1);
                        } else {
                            const int d0 = (wc - 2) * 32 + 8 * fq;
                            bf16_t* vp = Vt + ((size_t)(b * NH + hd) * DV + d0) * TP + vpos(t);
#pragma unroll
                            for (int j = 0; j < 4; ++j) { vp[(size_t)j * TP] = f2bf(v0[j]); vp[(size_t)(4 + j) * TP] = f2bf(v1[j]); }
                            if (wc == 2) *(u32x4*)(krow + 64 + 8 * fq) = *(const u32x4*)(KR + (size_t)row * 32 + 8 * fq);
                        }
                    }
                }
            }
    }
};

struct Params { const float* in[29]; float* out; unsigned char* ws; int ph_lo, ph_hi; };
struct PV { const Params& P; int z; int tid; int bx; int G; unsigned char* wsp; float* outp;
    DI const float* in(int k) const { return (const float*)(const GAS float*)P.in[k + z]; }
    DI unsigned char* ws() const { return wsp; }
    DI float* out() const { return outp; } };
DI PV mkpv(const Params& P) {
    int z = opq_s(); int tid = opq_tid(); int bx = blockIdx.x; int G = gridDim.x; unsigned char* w = launder_g(P.ws); float* o = launder_g(P.out);
    asm volatile("" : "+s"(bx)); asm volatile("" : "+s"(G));
    return PV{P, z, tid, bx, G, w, o};
}
#define MKPV(P) mkpv(P)

template <class CM>
DI void wprep_item(const CM cm, int it, int ldsrc, bf16_t* Bt, int Nrows, int ldb, int dst_k0, const float* kscale, LAS float* scr, int lane) {
    const int nblk = Nrows / 32;
    const int kb = it / nblk, nb = it - kb * nblk, k0 = 64 * kb, n0 = 32 * nb;
    const float* sp = cm(n0 + (lane & 31));
#pragma unroll
    for (int i = 0; i < 32; ++i) { const int kk = 2 * i + (lane >> 5); float v = 0.f; if (sp) { v = __builtin_nontemporal_load(sp + (size_t)(k0 + kk) * ldsrc); if (kscale) v *= kscale[k0 + kk]; } scr[kk * 33 + (lane & 31)] = v; }
    asm volatile("s_waitcnt lgkmcnt(0)" ::: "memory");
    const int c = lane & 7;
#pragma unroll
    for (int j = 0; j < 4; ++j) { const int n = (lane >> 3) + 8 * j; const LAS float* s = scr + (8 * c) * 33 + n;
        u32x4 o; o.x = cvt_pk(s[0 * 33], s[1 * 33]); o.y = cvt_pk(s[2 * 33], s[3 * 33]); o.z = cvt_pk(s[4 * 33], s[5 * 33]); o.w = cvt_pk(s[6 * 33], s[7 * 33]);
        *(u32x4*)(Bt + (size_t)(n0 + n) * ldb + dst_k0 + k0 + 8 * c) = o; }
    asm volatile("s_waitcnt lgkmcnt(0)" ::: "memory");
}
struct CMPlain { const float* W; DI const float* operator()(int p) const { return W + p; } };
struct CMGateUp { const float* Wg; const float* Wu; DI const float* operator()(int p) const { const int tile = p >> 8, w = p & 255; const long d = (w < 128) ? 0 : (long)(Wu - Wg); return Wg + d + tile * 128 + (w & 127); } };
DI int rope_src(int pp) { const int g = pp >> 3, e = pp & 7; return (e < 4) ? (4 * g + e) : (16 + 4 * g + (e - 4)); }
struct CMIn { const float* W; DI const float* operator()(int p) const { if (p < 1664) return W + p; if (p < 1696) return W + 1664 + rope_src(p - 1664); return nullptr; } };
struct CMQ { const float* W; DI const float* operator()(int p) const { const int hd = p / 96, dd = p - hd * 96; return W + hd * 96 + (dd < 64 ? dd : 64 + rope_src(dd - 64)); } };

DI void wprep_layer(const Params& P0, int l, LAS unsigned char* lds) {
    const PV P = MKPV(P0);
    const int lane = P.tid & 63, wid = P.tid >> 6;
    const int gw = P.bx * 8 + wid, NGW = P.G * 8;
    LAS float* scr = (LAS float*)(lds + wid * 8704);
    unsigned char* wb = P.ws() + WS_W;
    const size_t ffw = (size_t)D * DFF;
    constexpr int I_GU = (D / 64) * (NGU / 32), I_D = (DFF / 64) * (D / 32), I_IN = (D / 64) * (NIN / 32), I_UQ = (QL / 64) * (NQ / 32), I_UKV = (KVL / 64) * (NKV / 32),
                  I_O = (512 / 64) * (D / 32), I_LRU = 32;
    constexpr int E0 = I_GU, E1 = E0 + I_D, E2 = E1 + I_GU, E3 = E2 + I_D, E4 = E3 + I_IN, E5 = E4 + I_O, E6 = E5 + I_O, E7 = E6 + I_UQ, E8 = E7 + I_UKV, E9 = E8 + I_LRU;
    for (int it = gw; it < E9; it += NGW) {
        if (it < E0) wprep_item(CMGateUp{P.in(3) + l * ffw, P.in(4) + l * ffw}, it, DFF, (bf16_t*)(wb + WO_GU1), NGU, D, 0, P.in(2) + l * D, scr, lane);
        else if (it < E1) wprep_item(CMPlain{P.in(5) + l * ffw}, it - E0, D, (bf16_t*)(wb + WO_D1), D, DFF, 0, nullptr, scr, lane);
        else if (it < E2) wprep_item(CMGateUp{P.in(25) + l * ffw, P.in(26) + l * ffw}, it - E1, DFF, (bf16_t*)(wb + WO_GU2), NGU, D, 0, P.in(24) + l * D, scr, lane);
        else if (it < E3) wprep_item(CMPlain{P.in(27) + l * ffw}, it - E2, D, (bf16_t*)(wb + WO_D2), D, DFF, 0, nullptr, scr, lane);
        else if (it < E4) wprep_item(CMIn{P.in(8) + (size_t)l * D * 1696}, it - E3, 1696, (bf16_t*)(wb + WO_IN), NIN, D, 0, P.in(7) + l * D, scr, lane);
        else if (it < E5) wprep_item(CMPlain{P.in(22) + (size_t)l * D * D + (size_t)512 * D}, it - E4, D, (bf16_t*)(wb + WO_OUT), D, D, 0, P.in(21) + l * 512, scr, lane);
        else if (it < E6) wprep_item(CMPlain{P.in(22) + (size_t)l * D * D}, it - E5, D, (bf16_t*)(wb + WO_OUT), D, D, 512, nullptr, scr, lane);
        else if (it < E7) wprep_item(CMQ{P.in(17) + (size_t)l * QL * NQ}, it - E6, NQ, (bf16_t*)(wb + WO_UQ), NQ, QL, 0, P.in(16) + l * QL, scr, lane);
        else if (it < E8) wprep_item(CMPlain{P.in(19) + (size_t)l * KVL * NKV}, it - E7, NKV, (bf16_t*)(wb + WO_UKV), NKV, KVL, 0, P.in(18) + l * KVL, scr, lane);
        else {
            const int r = it - E8, q = r >> 1, hd = q >> 1, mat = q & 1;
            wprep_item(CMPlain{P.in(mat ? 13 : 11) + (size_t)l * 8 * 4096 + hd * 4096}, r & 1, 64, (bf16_t*)(wb + WO_LRU) + (size_t)q * 4096, 64, 64, 0, nullptr, scr, lane);
        }
    }
}

DI void unpack8(const u32x4 w, f32x4& a, f32x4& b) { a = (f32x4){bflo(w.x), bfhi(w.x), bflo(w.y), bfhi(w.y)}; b = (f32x4){bflo(w.z), bfhi(w.z), bflo(w.w), bfhi(w.w)}; }
DI float lo_dec1(unsigned hb16, int q) { return __uint_as_float((hb16 << 16) + (unsigned)(q << 8)); }
DI unsigned lo_enc1(float h, unsigned hb16) {
    int qi = ((int)(__float_as_uint(h) - (hb16 << 16)) + 128) >> 8;
    qi = qi > 127 ? 127 : qi;
    return (unsigned)qi & 0xFFu;
}
DI void lo_dec8(const u32x4 hw, const u32x2 lw, f32x4& a, f32x4& b) {
    const unsigned w[4] = {hw.x, hw.y, hw.z, hw.w};
#pragma unroll
    for (int k = 0; k < 4; ++k) {
        a[k] = lo_dec1((k & 1) ? (w[k >> 1] >> 16) : (w[k >> 1] & 0xFFFFu), (int)(lw.x << (24 - 8 * k)) >> 24);
        b[k] = lo_dec1((k & 1) ? (w[2 + (k >> 1)] >> 16) : (w[2 + (k >> 1)] & 0xFFFFu), (int)(lw.y << (24 - 8 * k)) >> 24);
    }
}
DI u32x2 lo_enc8(const f32x4 a, const f32x4 b, const u32x4 hw) {
    const unsigned w[4] = {hw.x, hw.y, hw.z, hw.w};
    u32x2 r; r.x = 0u; r.y = 0u;
#pragma unroll
    for (int k = 0; k < 4; ++k) {
        r.x |= lo_enc1(a[k], (k & 1) ? (w[k >> 1] >> 16) : (w[k >> 1] & 0xFFFFu)) << (8 * k);
        r.y |= lo_enc1(b[k], (k & 1) ? (w[2 + (k >> 1)] >> 16) : (w[2 + (k >> 1)] & 0xFFFFu)) << (8 * k);
    }
    return r;
}
template <int MODE>
DI void row_pass(const Params& P0, int gain_idx, int l, float coef, size_t part_off, int nchunk, bool final_out) {
    const PV P = MKPV(P0);
    const int lane = P.tid & 63, wid = P.tid >> 6;
    const int gw = P.bx * 8 + wid, NGW = P.G * 8;
    unsigned char* LO = (unsigned char*)(P.ws() + WS_H); bf16_t* HB = (bf16_t*)(P.ws() + WS_HB); const bf16_t* FY = (const bf16_t*)(P.ws() + WS_FY);
    float* rsh = (float*)(P.ws() + WS_RSH);
    constexpr int R = 4;
    f32x4 gv[4];
    if (MODE == 1) { const f32x4* gp = (const f32x4*)(P.in(gain_idx) + l * D); gv[0] = gp[2 * lane]; gv[1] = gp[2 * lane + 1]; gv[2] = gp[128 + 2 * lane]; gv[3] = gp[129 + 2 * lane]; }
    const float* PART = (const float*)(P.ws() + part_off);
    for (int row0 = gw; row0 < M; row0 += R * NGW) {
        f32x4 hv[R][4]; u32x4 f0[R], f1[R], h0[R], h1[R]; u32x2 l0[R], l1[R];
#pragma unroll
        for (int q = 0; q < R; ++q) {
            const int row = row0 + q * NGW;
            if (row < M) {
                if (MODE == 0) {
                    const int b = row / T, t = row - b * T;
                    const f32x4* sp = (const f32x4*)((t < NMETA) ? (P.in(1) + (size_t)t * D) : (P.in(0) + ((size_t)b * SEQ + (t - NMETA)) * D));
                    hv[q][0] = __builtin_nontemporal_load(sp + 2 * lane); hv[q][1] = __builtin_nontemporal_load(sp + 2 * lane + 1); hv[q][2] = __builtin_nontemporal_load(sp + 128 + 2 * lane); hv[q][3] = __builtin_nontemporal_load(sp + 129 + 2 * lane);
                } else {
                    if (row < 32768) { const u32x4* fp = (const u32x4*)(FY + (size_t)row * D); f0[q] = fp[lane]; f1[q] = fp[64 + lane]; }
                    else {
                        f32x4 a0 = (f32x4){0.f, 0.f, 0.f, 0.f}, a1 = a0, a2 = a0, a3 = a0;
                        for (int c = 0; c < nchunk; ++c) { const f32x4* pp = (const f32x4*)(PART + ((size_t)c * 128 + (row - 32768)) * D); a0 += pp[2 * lane]; a1 += pp[2 * lane + 1]; a2 += pp[128 + 2 * lane]; a3 += pp[129 + 2 * lane]; }
                        f0[q] = pack8(a0, a1); f1[q] = pack8(a2, a3);
                    }
                    const u32x4* hp = (const u32x4*)(HB + (size_t)row * D); h0[q] = __builtin_nontemporal_load(hp + lane); h1[q] = __builtin_nontemporal_load(hp + 64 + lane);
                    const u32x2* lp = (const u32x2*)(LO + (size_t)row * D); l0[q] = __builtin_nontemporal_load(lp + lane); l1[q] = __builtin_nontemporal_load(lp + 64 + lane);
                }
            }
        }
#pragma unroll
        for (int q = 0; q < R; ++q) {
            const int row = row0 + q * NGW;
            if (row < M) {
                const int b = row / T, t = row - b * T;
                if (MODE == 1) {
                    f32x4 fv[4];
                    unpack8(f0[q], fv[0], fv[1]); unpack8(f1[q], fv[2], fv[3]);
                    lo_dec8(h0[q], l0[q], hv[q][0], hv[q][1]); lo_dec8(h1[q], l1[q], hv[q][2], hv[q][3]);
                    float ss = 0.f;
#pragma unroll
                    for (int j = 0; j < 4; ++j) ss += (fv[j][0] * fv[j][0] + fv[j][1] * fv[j][1]) + (fv[j][2] * fv[j][2] + fv[j][3] * fv[j][3]);
                    ss = wave_sum(ss);
                    const float rn = rsqrtf(ss * (1.0f / D) + EPS) * coef;
#pragma unroll
                    for (int j = 0; j < 4; ++j) hv[q][j] = hv[q][j] + fv[j] * rn * gv[j];
                }
                if (final_out) {
                    if (t >= NMETA) {
                        f32x4* op = (f32x4*)(P.out() + ((size_t)b * SEQ + (t - NMETA)) * D);
                        __builtin_nontemporal_store(hv[q][0], op + 2 * lane); __builtin_nontemporal_store(hv[q][1], op + 2 * lane + 1); __builtin_nontemporal_store(hv[q][2], op + 128 + 2 * lane); __builtin_nontemporal_store(hv[q][3], op + 129 + 2 * lane);
                    }
                } else {
                    float s2 = 0.f;
#pragma unroll
                    for (int j = 0; j < 4; ++j) s2 += (hv[q][j][0] * hv[q][j][0] + hv[q][j][1] * hv[q][j][1]) + (hv[q][j][2] * hv[q][j][2] + hv[q][j][3] * hv[q][j][3]);
                    s2 = wave_sum(s2);
                    const u32x4 hb0 = pack8(hv[q][0], hv[q][1]), hb1 = pack8(hv[q][2], hv[q][3]);
                    u32x4* bp = (u32x4*)(HB + (size_t)row * D); bp[lane] = hb0; bp[64 + lane] = hb1;
                    u32x2* lp = (u32x2*)(LO + (size_t)row * D); __builtin_nontemporal_store(lo_enc8(hv[q][0], hv[q][1], hb0), lp + lane); __builtin_nontemporal_store(lo_enc8(hv[q][2], hv[q][3], hb1), lp + 64 + lane);
                    if (lane == 0) rsh[row] = rsqrtf(s2 * (1.0f / D) + EPS);
                }
            }
        }
    }
}

DI void lru_local(const Params& P0, int l, LAS unsigned char* lds) {
    const PV P = MKPV(P0);
    const int tid = P.tid, lane = tid & 63, wid = tid >> 6, r = lane & 31, hh = lane >> 5;
    const bf16_t* Z = (const bf16_t*)(P.ws() + WS_Z);
    const bf16_t* LW = (const bf16_t*)(P.ws() + WS_W + WO_LRU);
    bf16_t* HLOC = (bf16_t*)((unsigned char*)P.out() + DO_HLOC); bf16_t* PA = (bf16_t*)((unsigned char*)P.out() + DO_PA);
    float* AAGG = (float*)(P.ws() + WS_AAGG); float* BAGG = (float*)(P.ws() + WS_BAGG);
    LAS bf16_t* xcs = (LAS bf16_t*)lds;
    bf16x8 wf[2][2][4];
#pragma unroll
    for (int mat = 0; mat < 2; ++mat)
#pragma unroll
        for (int nb = 0; nb < 2; ++nb)
#pragma unroll
            for (int s = 0; s < 4; ++s) wf[mat][nb][s] = *(const bf16x8*)(LW + ((size_t)((wid * 2 + mat) * 64 + nb * 32 + r)) * 64 + 16 * s + 8 * hh);
    float ba[2], bx[2], c8[2];
#pragma unroll
    for (int nb = 0; nb < 2; ++nb) { const int ch = 64 * wid + 32 * nb + r; ba[nb] = P.in(12)[l * LRUW + ch]; bx[nb] = P.in(14)[l * LRUW + ch];
        c8[nb] = -8.0f * log1pf(expf(-P.in(15)[l * LRUW + ch])); }
    const float cw0 = P.in(9)[(l * 4 + 0) * LRUW + tid], cw1 = P.in(9)[(l * 4 + 1) * LRUW + tid], cw2 = P.in(9)[(l * 4 + 2) * LRUW + tid], cw3 = P.in(9)[(l * 4 + 3) * LRUW + tid];
    const float cbias = P.in(10)[l * LRUW + tid];
    for (int unit = P.bx; unit < NB * NCH; unit += P.G) {
        const int b = unit / NCH, c = unit - b * NCH, t0 = 32 * c;
        {
            const bf16_t* zr = Z + (size_t)(b * T + t0) * LDZ + tid;
            float xm3 = 0.f, xm2 = 0.f, xm1 = 0.f;
            if (t0 > 0) { xm3 = bf2f(zr[-3 * LDZ]); xm2 = bf2f(zr[-2 * LDZ]); xm1 = bf2f(zr[-1 * LDZ]); }
#pragma unroll 8
            for (int tt = 0; tt < 32; ++tt) {
                const float x = bf2f(zr[(size_t)tt * LDZ]);
                const float xc = cbias + cw3 * x + cw2 * xm1 + cw1 * xm2 + cw0 * xm3;
                xcs[tt * 520 + tid] = f2bf(xc);
                xm3 = xm2; xm2 = xm1; xm1 = x;
            }
        }
        __syncthreads();
        f32x16 accR[2], accI[2];
#pragma unroll
        for (int nb = 0; nb < 2; ++nb) { accR[nb] = f32x16{}; accI[nb] = f32x16{}; }
#pragma unroll
        for (int s = 0; s < 4; ++s) {
            const bf16x8 a = *(const LAS bf16x8*)(xcs + r * 520 + 64 * wid + 16 * s + 8 * hh);
#pragma unroll
            for (int nb = 0; nb < 2; ++nb) {
                accR[nb] = __builtin_amdgcn_mfma_f32_32x32x16_bf16(a, wf[0][nb][s], accR[nb], 0, 0, 0);
                accI[nb] = __builtin_amdgcn_mfma_f32_32x32x16_bf16(a, wf[1][nb][s], accI[nb], 0, 0, 0);
            }
        }
#pragma unroll
        for (int nb = 0; nb < 2; ++nb) {
            const int ch = 64 * wid + 32 * nb + r;
            float av[16], bv[16];
#pragma unroll
            for (int i = 0; i < 16; ++i) {
                const float rg = sigmoidf_(accR[nb][i] + ba[nb]);
                const float ig = sigmoidf_(accI[nb][i] + bx[nb]);
                const float la = c8[nb] * rg;
                const float a = __expf(la);
                const float xc = bf2f(xcs[crow(i, hh) * 520 + ch]);
                av[i] = a; bv[i] = __builtin_amdgcn_sqrtf(fmaxf(__builtin_fmaf(-a, a, 1.0f), 0.f)) * (ig * xc);
            }
            float cin = 0.f, pin = 1.f, hcur = 0.f, pcur = 1.f;
            float ho[16], po[16];
#pragma unroll
            for (int g = 0; g < 4; ++g) {
                hcur = cin; pcur = pin;
#pragma unroll
                for (int e = 0; e < 4; ++e) { hcur = av[4 * g + e] * hcur + bv[4 * g + e]; pcur *= av[4 * g + e]; if (hh == 0) { ho[4 * g + e] = hcur; po[4 * g + e] = pcur; } }
                { const float hx = other_x32(hcur, hh), px = other_x32(pcur, hh); if (hh == 1) { cin = hx; pin = px; } }
                hcur = cin; pcur = pin;
#pragma unroll
                for (int e = 0; e < 4; ++e) { hcur = av[4 * g + e] * hcur + bv[4 * g + e]; pcur *= av[4 * g + e]; if (hh == 1) { ho[4 * g + e] = hcur; po[4 * g + e] = pcur; } }
                { const float hx = other_x32(hcur, hh), px = other_x32(pcur, hh); if (hh == 0) { cin = hx; pin = px; } }
            }
            if (hh == 1) { AAGG[(size_t)(b * NCH + c) * LRUW + ch] = pcur; BAGG[(size_t)(b * NCH + c) * LRUW + ch] = hcur; }
#pragma unroll
            for (int i = 0; i < 16; ++i) {
                const int t = t0 + crow(i, hh);
                if (t < T) { const size_t o = (size_t)(b * T + t) * LRUW + ch; HLOC[o] = f2bf(ho[i]); PA[o] = f2bf(po[i]); }
            }
        }
        __syncthreads();
    }
}

DI void lru_final(const Params& P0, int l, LAS unsigned char* lds) {
    const PV P = MKPV(P0);
    const int tid = P.tid;
    const bf16_t* Z = (const bf16_t*)(P.ws() + WS_Z);
    const bf16_t* HLOC = (const bf16_t*)((unsigned char*)P.out() + DO_HLOC); const bf16_t* PA = (const bf16_t*)((unsigned char*)P.out() + DO_PA);
    const float* AAGG = (const float*)(P.ws() + WS_AAGG); const float* BAGG = (const float*)(P.ws() + WS_BAGG);
    bf16_t* AOUT = (bf16_t*)(P.ws() + WS_AOUT);
    LAS float* carry = (LAS float*)lds;
    const int tok = tid >> 4, cg16 = tid & 15;
    const int nun = NB * NCH, base = nun / P.G, rem = nun - base * P.G;
    const int u0 = P.bx * base + (P.bx < rem ? P.bx : rem), u1 = u0 + base + (P.bx < rem ? 1 : 0);
    if (u0 >= u1) return;
    f32x4 gg[8];
    { const f32x4* gp = (const f32x4*)(P.in(20) + l * LRUW + cg16 * 32);
#pragma unroll
      for (int q = 0; q < 8; ++q) gg[q] = gp[q]; }
    u32x4 hw[4], pw[4], gw[4]; float an = 0.f, bn = 0.f;
#define LF_LOAD(U, H_, P_, G_, A_, B_) do { const int b_ = (U) / NCH, c_ = (U) - b_ * NCH, t_ = 32 * c_ + tok; \
        A_ = AAGG[(size_t)(b_ * NCH + c_) * LRUW + tid]; B_ = BAGG[(size_t)(b_ * NCH + c_) * LRUW + tid]; \
        if (t_ < T) { const size_t row_ = (size_t)b_ * T + t_; \
            const u32x4* hp_ = (const u32x4*)(HLOC + row_ * LRUW + cg16 * 32); const u32x4* pp_ = (const u32x4*)(PA + row_ * LRUW + cg16 * 32); const u32x4* gp_ = (const u32x4*)(Z + row_ * LDZ + 512 + cg16 * 32); \
            _Pragma("unroll") for (int q = 0; q < 4; ++q) { H_[q] = hp_[q]; P_[q] = pp_[q]; G_[q] = gp_[q]; } } } while (0)
    LF_LOAD(u0, hw, pw, gw, an, bn);
    float cr = 0.f;
    {
        const int b = u0 / NCH, c = u0 - b * NCH;
        const float* ap = AAGG + (size_t)b * NCH * LRUW + tid; const float* bp = BAGG + (size_t)b * NCH * LRUW + tid;
        int j = 0;
        for (; j + 16 <= c; j += 16) {
            float aa[16], bb[16];
#pragma unroll
            for (int k = 0; k < 16; ++k) { aa[k] = ap[(size_t)(j + k) * LRUW]; bb[k] = bp[(size_t)(j + k) * LRUW]; }
#pragma unroll
            for (int k = 0; k < 16; ++k) cr = aa[k] * cr + bb[k];
        }
        for (; j < c; ++j) cr = ap[(size_t)j * LRUW] * cr + bp[(size_t)j * LRUW];
    }
    for (int unit = u0; unit < u1; ++unit) {
        const int b = unit / NCH, c = unit - b * NCH, t0 = 32 * c;
        carry[(tid >> 5) * 33 + (tid & 31)] = cr;
        __syncthreads();
        u32x4 hn[4], pn[4], gn[4]; float an2 = 0.f, bn2 = 0.f;
#pragma unroll
        for (int q = 0; q < 4; ++q) { hn[q] = hw[q]; pn[q] = pw[q]; gn[q] = gw[q]; }
        if (unit + 1 < u1) LF_LOAD(unit + 1, hn, pn, gn, an2, bn2);
        const int t = t0 + tok;
        if (t < T) {
            const size_t row = (size_t)b * T + t;
            float y[32]; float ss = 0.f;
#pragma unroll
            for (int q = 0; q < 4; ++q) {
                const unsigned hws[4] = {hw[q].x, hw[q].y, hw[q].z, hw[q].w}, pws[4] = {pw[q].x, pw[q].y, pw[q].z, pw[q].w}, gws[4] = {gw[q].x, gw[q].y, gw[q].z, gw[q].w};
#pragma unroll
                for (int k = 0; k < 4; ++k) {
                    const int e = q * 8 + 2 * k;
                    const float c0 = carry[cg16 * 33 + e], c1 = carry[cg16 * 33 + e + 1];
                    const float y0 = (bflo(hws[k]) + bflo(pws[k]) * c0) * gelu_tanh(bflo(gws[k]));
                    const float y1 = (bfhi(hws[k]) + bfhi(pws[k]) * c1) * gelu_tanh(bfhi(gws[k]));
                    y[e] = y0; y[e + 1] = y1; ss += y0 * y0 + y1 * y1;
                }
            }
            ss += sx<1>(ss); ss += sx<2>(ss); ss += sx<4>(ss); ss += sx<8>(ss);
            const float rn = rsqrtf(ss * (1.0f / LRUW) + EPS);
            u32x4* op = (u32x4*)(AOUT + row * D + 512 + cg16 * 32);
#pragma unroll
            for (int q = 0; q < 4; ++q) {
                const f32x4 ga = gg[2 * q], gb = gg[2 * q + 1];
                u32x4 w;
                w.x = cvt_pk(y[8 * q + 0] * rn * ga[0], y[8 * q + 1] * rn * ga[1]);
                w.y = cvt_pk(y[8 * q + 2] * rn * ga[2], y[8 * q + 3] * rn * ga[3]);
                w.z = cvt_pk(y[8 * q + 4] * rn * gb[0], y[8 * q + 5] * rn * gb[1]);
                w.w = cvt_pk(y[8 * q + 6] * rn * gb[2], y[8 * q + 7] * rn * gb[3]);
                op[q] = w;
            }
        }
        __syncthreads();
        cr = (c + 1 == NCH) ? 0.f : an * cr + bn;
#pragma unroll
        for (int q = 0; q < 4; ++q) { hw[q] = hn[q]; pw[q] = pn[q]; gw[q] = gn[q]; }
        an = an2; bn = bn2;
    }
#undef LF_LOAD
}

constexpr int AK_ROW = 208, AV_ROW = 144, AK_BYTES = 64 * AK_ROW, AV_BYTES = 64 * AV_ROW;
constexpr int APAIR = 2 * AK_BYTES + 2 * AV_BYTES;
DI void qk_tile(f32x16& p0, f32x16& p1, const LAS unsigned char* Kb, const bf16x8 (&qf)[6], const f32x16& negm, int r, int hh) {
    bf16x8 kf[12];
#pragma unroll
    for (int s = 0; s < 6; ++s) {
        kf[2 * s] = *(const LAS bf16x8*)(Kb + r * AK_ROW + (16 * s + 8 * hh) * 2);
        kf[2 * s + 1] = *(const LAS bf16x8*)(Kb + (32 + r) * AK_ROW + (16 * s + 8 * hh) * 2);
    }
    p0 = __builtin_amdgcn_mfma_f32_32x32x16_bf16(kf[0], qf[0], negm, 0, 0, 0);
    p1 = __builtin_amdgcn_mfma_f32_32x32x16_bf16(kf[1], qf[0], negm, 0, 0, 0);
#pragma unroll
    for (int s = 1; s < 6; ++s) {
        p0 = __builtin_amdgcn_mfma_f32_32x32x16_bf16(kf[2 * s], qf[s], p0, 0, 0, 0);
        p1 = __builtin_amdgcn_mfma_f32_32x32x16_bf16(kf[2 * s + 1], qf[s], p1, 0, 0, 0);
    }
}
DI void pv_tile(f32x16 (&o)[2], const LAS unsigned char* Vb, const f32x16& p0, const f32x16& p1, int r, int hh) {
    bf16x8 vf[8];
#pragma unroll
    for (int db = 0; db < 2; ++db)
#pragma unroll
        for (int s = 0; s < 4; ++s) vf[db * 4 + s] = *(const LAS bf16x8*)(Vb + (32 * db + r) * AV_ROW + (16 * s + 8 * hh) * 2);
    bf16x8 pw[4];
#pragma unroll
    for (int s = 0; s < 2; ++s) {
        u32x4 w0, w1;
        w0.x = cvt_pk(p0[8 * s + 0], p0[8 * s + 1]); w0.y = cvt_pk(p0[8 * s + 2], p0[8 * s + 3]); w0.z = cvt_pk(p0[8 * s + 4], p0[8 * s + 5]); w0.w = cvt_pk(p0[8 * s + 6], p0[8 * s + 7]);
        w1.x = cvt_pk(p1[8 * s + 0], p1[8 * s + 1]); w1.y = cvt_pk(p1[8 * s + 2], p1[8 * s + 3]); w1.z = cvt_pk(p1[8 * s + 4], p1[8 * s + 5]); w1.w = cvt_pk(p1[8 * s + 6], p1[8 * s + 7]);
        pw[s] = __builtin_bit_cast(bf16x8, w0); pw[2 + s] = __builtin_bit_cast(bf16x8, w1);
    }
#pragma unroll
    for (int db = 0; db < 2; ++db)
#pragma unroll
        for (int s = 0; s < 4; ++s) o[db] = __builtin_amdgcn_mfma_f32_32x32x16_bf16(vf[db * 4 + s], pw[s], o[db], 0, 0, 0);
}
DI float vmax16(const f32x16& a, const f32x16& b) {
    float m = __builtin_elementwise_maximum(a[0], b[0]);
#pragma unroll
    for (int i = 1; i < 16; ++i) m = __builtin_elementwise_maximum(__builtin_elementwise_maximum(m, a[i]), b[i]);
    return m;
}
constexpr float ATT_THR = 6.0f;
#define ATT_RESCALE(first, rm, SHIFT_STMT) do { \
        if ((first) || __any((rm) > ATT_THR)) { \
            const float dl = (first) ? (rm) : __builtin_elementwise_maximum((rm), 0.f); \
            mhat += dl; SHIFT_STMT; \
            const float f_ = __builtin_amdgcn_exp2f(-dl); lsum *= f_; \
            _Pragma("unroll") for (int i = 0; i < 16; ++i) { o[0][i] *= f_; o[1][i] *= f_; } \
            _Pragma("unroll") for (int i = 0; i < 16; ++i) negm[i] = -mhat; \
        } } while (0)
DI void attn_tile1(f32x16 (&o)[2], float& mhat, float& lsum, f32x16& negm, bool first, const LAS unsigned char* Kb, const LAS unsigned char* Vb, const bf16x8 (&qf)[6], int kv0, int qmin, int qrow, int r, int hh) {
    f32x16 p0, p1;
    qk_tile(p0, p1, Kb, qf, negm, r, hh);
    if (kv0 + 63 > qmin) {
#pragma unroll
        for (int i = 0; i < 16; ++i) { const int kv = kv0 + crow(i, hh); if (kv > qrow) p0[i] = -INFINITY; if (kv + 32 > qrow) p1[i] = -INFINITY; }
    }
    const float rm = max_x32(vmax16(p0, p1));
    ATT_RESCALE(first, rm, { _Pragma("unroll") for (int i = 0; i < 16; ++i) { p0[i] -= dl; p1[i] -= dl; } });
    float ps = 0.f;
#pragma unroll
    for (int i = 0; i < 16; ++i) { p0[i] = __builtin_amdgcn_exp2f(p0[i]); p1[i] = __builtin_amdgcn_exp2f(p1[i]); ps += p0[i] + p1[i]; }
    lsum += ps;
    pv_tile(o, Vb, p0, p1, r, hh);
}
DI void attn_tile2(f32x16 (&o)[2], float& mhat, float& lsum, f32x16& negm, bool first, const LAS unsigned char* KbA, const LAS unsigned char* VbA, const LAS unsigned char* KbB, const LAS unsigned char* VbB,
                   const bf16x8 (&qf)[6], int r, int hh) {
    f32x16 a0, a1, b0, b1;
    qk_tile(a0, a1, KbA, qf, negm, r, hh);
    qk_tile(b0, b1, KbB, qf, negm, r, hh);
    const float rm = max_x32(__builtin_elementwise_maximum(vmax16(a0, a1), vmax16(b0, b1)));
    ATT_RESCALE(first, rm, { _Pragma("unroll") for (int i = 0; i < 16; ++i) { a0[i] -= dl; a1[i] -= dl; b0[i] -= dl; b1[i] -= dl; } });
    float ps = 0.f, qs = 0.f;
#pragma unroll
    for (int i = 0; i < 16; ++i) { a0[i] = __builtin_amdgcn_exp2f(a0[i]); a1[i] = __builtin_amdgcn_exp2f(a1[i]); ps += a0[i] + a1[i]; }
    pv_tile(o, VbA, a0, a1, r, hh);
#pragma unroll
    for (int i = 0; i < 16; ++i) { b0[i] = __builtin_amdgcn_exp2f(b0[i]); b1[i] = __builtin_amdgcn_exp2f(b1[i]); qs += b0[i] + b1[i]; }
    lsum += ps + qs;
    pv_tile(o, VbB, b0, b1, r, hh);
}
DI void attn_unit(const PV& P, LAS unsigned char* lds, int bh, int q0, int nq) {
    const int tid = P.tid, lane = tid & 63, wid = __builtin_amdgcn_readfirstlane(tid >> 6), r = lane & 31, hh = lane >> 5;
    const bf16_t* Qg = (const bf16_t*)(P.ws() + WS_Q); const bf16_t* Kg = (const bf16_t*)(P.ws() + WS_K); const bf16_t* Vg = (const bf16_t*)(P.ws() + WS_VT);
    bf16_t* AOUT = (bf16_t*)(P.ws() + WS_AOUT); float* ssqm = (float*)(P.ws() + WS_SSQM);
    const int b = bh >> 3, hd = bh & 7;
    const int NT = (q0 + nq - 1) / 64 + 1;
    const bool active = (32 * wid) < nq;
    const int qmin = q0 + 32 * wid, qmax = qmin + 31, qrow = qmin + r;
    bf16x8 qf[6];
    {
        const bf16_t* qp = Qg + ((size_t)bh * TP + qrow) * DQK + 8 * hh;
#pragma unroll
        for (int s = 0; s < 6; ++s) qf[s] = *(const bf16x8*)(qp + 16 * s);
    }
    const unsigned char* kbase = (const unsigned char*)(Kg + (size_t)bh * TP * DQK);
    const unsigned char* vbase = (const unsigned char*)(Vg + (size_t)bh * DV * TP);
    unsigned koff[2], voff[2];
#pragma unroll
    for (int i = 0; i < 2; ++i) {
        const int pk = (wid + 8 * i) * 64 + lane, rk = pk / 13, ck = pk - rk * 13;
        koff[i] = (unsigned)((rk * 12 + (ck < 12 ? ck : 0)) * 16);
        const int pv = (wid + 8 * i) * 64 + lane, rv = pv / 9, cv = pv - rv * 9;
        voff[i] = (unsigned)((rv * TP + (cv < 8 ? cv : 0) * 8) * 2);
    }
#define ATT_DMA(t, buf, slot) do { const unsigned char* kt_ = kbase + (size_t)(t) * (64 * DQK * 2); const unsigned char* vt_ = vbase + (size_t)(t) * 128; \
        LAS unsigned char* kb_ = lds + (buf) * APAIR + (slot) * AK_BYTES; LAS unsigned char* vb_ = lds + (buf) * APAIR + 2 * AK_BYTES + (slot) * AV_BYTES; \
        __builtin_amdgcn_global_load_lds((const unsigned*)(kt_ + koff[0]), (LAS unsigned*)(kb_ + wid * 1024), 16, 0, 0); \
        if (wid < 5) __builtin_amdgcn_global_load_lds((const unsigned*)(kt_ + koff[1]), (LAS unsigned*)(kb_ + (wid + 8) * 1024), 16, 0, 0); \
        __builtin_amdgcn_global_load_lds((const unsigned*)(vt_ + voff[0]), (LAS unsigned*)(vb_ + wid * 1024), 16, 0, 0); \
        if (wid < 1) __builtin_amdgcn_global_load_lds((const unsigned*)(vt_ + voff[1]), (LAS unsigned*)(vb_ + (wid + 8) * 1024), 16, 0, 0); } while (0)
    ATT_DMA(0, 0, 0); if (NT > 1) ATT_DMA(1, 0, 1);
    asm volatile("s_waitcnt vmcnt(0)" ::: "memory");
    __syncthreads();
    f32x16 o[2]; o[0] = f32x16{}; o[1] = f32x16{};
    float mhat = 0.f, lsum = 0.f;
    f32x16 negm = f32x16{};
    for (int j = 0; j < NT; j += 2) {
        const int cur = (j >> 1) & 1;
        if (j + 2 < NT) ATT_DMA(j + 2, cur ^ 1, 0);
        if (j + 3 < NT) ATT_DMA(j + 3, cur ^ 1, 1);
        const LAS unsigned char* KbA = lds + cur * APAIR; const LAS unsigned char* KbB = KbA + AK_BYTES;
        const LAS unsigned char* VbA = KbA + 2 * AK_BYTES; const LAS unsigned char* VbB = VbA + AV_BYTES;
        const bool doA = active && (64 * j <= qmax);
        const bool doB = active && (j + 1 < NT) && (64 * (j + 1) <= qmax);
        if (doB && (64 * (j + 1) + 63 <= qmin)) {
            attn_tile2(o, mhat, lsum, negm, j == 0, KbA, VbA, KbB, VbB, qf, r, hh);
        } else {
            if (doA) attn_tile1(o, mhat, lsum, negm, j == 0, KbA, VbA, qf, 64 * j, qmin, qrow, r, hh);
            if (doB) attn_tile1(o, mhat, lsum, negm, false, KbB, VbB, qf, 64 * (j + 1), qmin, qrow, r, hh);
        }
        asm volatile("s_waitcnt vmcnt(0)" ::: "memory");
        __syncthreads();
    }
#undef ATT_DMA
    if (active) {
        const float ltot = sum_x32(lsum);
        const float inv = 1.0f / ltot;
        float ss = 0.f;
#pragma unroll
        for (int db = 0; db < 2; ++db)
#pragma unroll
            for (int i = 0; i < 16; ++i) { o[db][i] *= inv; ss += o[db][i] * o[db][i]; }
        ss = sum_x32(ss);
        if (32 * wid + r < nq) {
            const size_t row = (size_t)b * T + qrow;
            bf16_t* dst = AOUT + row * D + hd * DV;
#pragma unroll
            for (int db = 0; db < 2; ++db)
#pragma unroll
                for (int g4 = 0; g4 < 4; ++g4) {
                    u32x2 w; w.x = cvt_pk(o[db][4 * g4 + 0], o[db][4 * g4 + 1]); w.y = cvt_pk(o[db][4 * g4 + 2], o[db][4 * g4 + 3]);
                    *(u32x2*)(dst + 32 * db + 8 * g4 + 4 * hh) = w;
                }
            if (hh == 0) ssqm[row * 8 + hd] = ss;
        }
    }
}
DI void attn_phase(const Params& P0, LAS unsigned char* lds) {
    const PV P = MKPV(P0);
    const int vcu = ((P.G & 7) == 0) ? ((P.bx & 7) * (P.G >> 3) + (P.bx >> 3)) : P.bx;
    for (int w = vcu; w < 64 * 8; w += P.G) {
        const int bh = w >> 3, p = w & 7;
        attn_unit(P, lds, bh, 16 + 256 * (15 - p), 256);
        attn_unit(P, lds, bh, 16 + 256 * p, 256);
    }
    for (int w = P.bx; w < 64; w += P.G) attn_unit(P, lds, w, 0, 16);
}


#define XB_TMO      128
#define XB_XCNT(j)  (256  + 64 * (j))
#define XB_XSUB(j)  (1280 + 64 * (j))
#define XB_XGEN(j)  (2304 + 64 * (j))
#define XB_TOP      3328
#define XB_TOPGEN   3392
#define XCD_BAR_WORDS 3456
#define XB_SPIN_CAP (1u << 18)
DI unsigned xb_ld(unsigned* p)              { return __hip_atomic_load(p, __ATOMIC_RELAXED, __HIP_MEMORY_SCOPE_AGENT); }
DI unsigned xb_add(unsigned* p, unsigned v) { return __hip_atomic_fetch_add(p, v, __ATOMIC_RELAXED, __HIP_MEMORY_SCOPE_AGENT); }
DI unsigned xb_xcc_id() { return (unsigned)__builtin_amdgcn_s_getreg((3 << 11) | 20) & 0xFu; }
#define XB_SPIN(cond, bar) do { unsigned _sp = 0; while (cond) { __builtin_amdgcn_s_sleep(1); \
    if ((++_sp & 255u) == 0u) { if (xb_ld(&(bar)[XB_TMO])) break; if (_sp > XB_SPIN_CAP) { atomicAdd(&(bar)[XB_TMO], 1u); break; } } } } while (0)
struct XcdBarrier { unsigned* bar; unsigned x; volatile LAS unsigned* st; };
DI void xcd_barrier_post(unsigned* bar) { if (threadIdx.x == 0) (void)xb_add(&bar[XB_XCNT(xb_xcc_id())], 1u); }
DI void xcd_barrier_complete(unsigned* bar, unsigned x, unsigned& nloc, unsigned& nx) {
    const unsigned G = gridDim.x * gridDim.y * gridDim.z;
    unsigned sum, cnt, mine, sp = 0u;
    for (;;) {
        sum = 0u; cnt = 0u; mine = 0u;
#pragma unroll
        for (unsigned j = 0; j < 16; ++j) { const unsigned c = xb_ld(&bar[XB_XCNT(j)]); sum += c; cnt += (c > 0u) ? 1u : 0u; mine = (j == x) ? c : mine; }
        if (sum == G) break;
        __builtin_amdgcn_s_sleep(1);
        if ((++sp & 255u) == 0u) { if (xb_ld(&bar[XB_TMO])) break; if (sp > XB_SPIN_CAP) { atomicAdd(&bar[XB_TMO], 1u); break; } }
    }
    nloc = mine > 0u ? mine : 1u; nx = cnt > 0u ? cnt : 1u;
}
DI void xcd_barrier(const XcdBarrier& b) {
    asm volatile("s_waitcnt vmcnt(0)" ::: "memory");
    __syncthreads();
    if (threadIdx.x == 0) {
        unsigned* bar = b.bar;
        __builtin_amdgcn_s_waitcnt(0);
        unsigned nloc = b.st[0], nx = b.st[1];
        if (nloc == 0u) { xcd_barrier_complete(bar, b.x, nloc, nx); b.st[0] = nloc; b.st[1] = nx; }
        const unsigned old = xb_add(&bar[XB_XSUB(b.x)], 1u);
        const unsigned gen = old / nloc;
        if (old + 1u == (gen + 1u) * nloc) {
            __builtin_amdgcn_fence(__ATOMIC_RELEASE, "agent");
            asm volatile("s_waitcnt vmcnt(0)" ::: "memory");
            const unsigned og = xb_add(&bar[XB_TOP], 1u);
            const unsigned tg = og / nx;
            if (og + 1u == (tg + 1u) * nx) xb_add(&bar[XB_TOPGEN], 1u);
            else XB_SPIN(xb_ld(&bar[XB_TOPGEN]) == tg, bar);
            __builtin_amdgcn_fence(__ATOMIC_ACQUIRE, "agent");
            xb_add(&bar[XB_XGEN(b.x)], 1u);
            asm volatile("s_waitcnt vmcnt(0)" ::: "memory");
        } else {
            XB_SPIN(xb_ld(&bar[XB_XGEN(b.x)]) == gen, bar);
            __builtin_amdgcn_fence(__ATOMIC_ACQUIRE, "agent");
            asm volatile("s_waitcnt vmcnt(0)" ::: "memory");
        }
    }
    __syncthreads();
}

#ifndef PHMASK
#define PHMASK 0xfff
#endif
#define PHON(k) ((PHMASK >> (k)) & 1)
#ifndef REPMASK
#define REPMASK 0
#endif
__global__ void __launch_bounds__(512, 2) mega_fwd(Params P) {
    extern __shared__ __attribute__((aligned(16))) unsigned char lds_raw[];
    LAS unsigned char* lds = (LAS unsigned char*)lds_raw;
    cg::grid_group grid = cg::this_grid();
    volatile LAS unsigned* bst = (volatile LAS unsigned*)(lds + 131072 + 64);
    if (threadIdx.x < 2) bst[threadIdx.x] = 0u;
    __syncthreads();
    xcd_barrier_post((unsigned*)(launder_g(P.ws) + WS_BAR));
    int rep = 0;
    for (int ph = P.ph_lo; ph < P.ph_hi; ++ph) {
        const PV V = mkpv(P);
        unsigned char* ws = V.wsp;
        const int G = V.G, bx = V.bx;
        if (ph == 0) {
          if (PHON(11)) {
            row_pass<0>(P, 0, 0, 0.f, 0, 0, false);
            {
                float* cosT = (float*)(ws + WS_COS); float* sinT = (float*)(ws + WS_SIN);
                for (int i = bx * 512 + opq_tid(); i < T * 16; i += G * 512) {
                    const int t = i >> 4, k = i & 15;
                    const float inv = 1.0f / powf(10000.0f, (float)(2 * k) / 32.0f);
                    const float ang = (float)t * inv;
                    cosT[i] = cosf(ang); sinT[i] = sinf(ang);
                }
            }
            wprep_layer(P, 0, lds);
          }
        } else {
            const int l = (ph - 1) / 11, s = (ph - 1) % 11;
            const unsigned char* wb = ws + WS_W;
            if (s == 0 || s == 8) {
              if (PHON(0)) {
                pg8::Gemm g{(const bf16_t*)(ws + WS_HB), (const bf16_t*)(wb + (s == 0 ? WO_GU1 : WO_GU2)), MP, NGU, D, D, D, 0};
                pg8::StaticOrder S; S.init(MP, NGU, G, bx);
                EpiGU E{ws};
                pg8::gemm_phase(lds, g, S, E);
              }
            } else if (s == 1 || s == 9) {
              if (PHON(1)) {
                {
                    pg8::Gemm g{(const bf16_t*)(ws + WS_ACT), (const bf16_t*)(wb + (s == 1 ? WO_D1 : WO_D2)), 32768, D, DFF, DFF, DFF, 0};
                    pg8::StaticOrder S; S.init(32768, D, G, bx);
                    EpiStore<false> E{ws};
                    pg8::gemm_phase(lds, g, S, E);
                }
                for (int ck = 0; ck < 11; ++ck) {
                    pg8::Gemm g{(const bf16_t*)(ws + WS_ACT) + (size_t)32768 * DFF + ck * 256, (const bf16_t*)(wb + (s == 1 ? WO_D1 : WO_D2)) + ck * 256, 256, D, 256, DFF, DFF, 32768};
                    pg8::StaticOrder S; S.init(256, D, G, (bx - 4 * ck + G) % G);
                    EpiPart E{ws, (float*)(ws + WS_PARTD) + (size_t)ck * 128 * D, 0};
                    pg8::gemm_phase(lds, g, S, E);
                }
              }
            } else if (s == 2) {
              if (PHON(2)) row_pass<1>(P, 6, l, 0.5f, WS_PARTD, 11, false);
            } else if (s == 3) {
              if (PHON(3)) {
                pg8::Gemm g{(const bf16_t*)(ws + WS_HB), (const bf16_t*)(wb + WO_IN), MP, NIN, D, D, D, 0};
                pg8::StaticOrder S; S.init(MP, NIN, G, bx);
                EpiIn E{ws, (unsigned char*)V.outp};
                pg8::gemm_phase(lds, g, S, E);
              }
            } else if (s == 4) {
              if (PHON(4)) {
                {
                    bf16_t* Vt = (bf16_t*)(ws + WS_VT);
                    const unsigned zu = (unsigned)opq_s();
                    for (int i = bx * 512 + opq_tid(); i < 64 * 64 * 6; i += G * 512) { const int rw = i / 6, cc = i - rw * 6; *(u32x4*)(Vt + (size_t)rw * TP + T + cc * 8) = (u32x4){zu, zu, zu, zu}; }
                }
                lru_local(P, l, lds);
              }
              if (PHON(5)) {
                {
                    pg8::Gemm g{(const bf16_t*)(ws + WS_Z) + 1024, (const bf16_t*)(wb + WO_UQ), MP, NQ, QL, LDZ, QL, 0};
                    pg8::StaticOrder S; S.init(MP, NQ, G, bx);
                    EpiQ E{ws};
                    pg8::gemm_phase(lds, g, S, E);
                }
              }
              if (PHON(6)) {
                {
                    pg8::Gemm g{(const bf16_t*)(ws + WS_Z) + 1408, (const bf16_t*)(wb + WO_UKV), MP, NKV, KVL, LDZ, KVL, 0};
                    pg8::StaticOrder S; S.init(MP, NKV, G, (G - 1) - bx);
                    EpiKV E{ws, (unsigned char*)V.outp};
                    pg8::gemm_phase(lds, g, S, E);
                }
              }
            } else if (s == 5) {
                if (PHON(7)) lru_final(P, l, lds);
                if (PHON(8)) attn_phase(P, lds);
            } else if (s == 6) {
              if (PHON(9)) {
                {
                    pg8::Gemm g{(const bf16_t*)(ws + WS_AOUT), (const bf16_t*)(wb + WO_OUT), 32768, D, D, D, D, 0};
                    pg8::StaticOrder S; S.init(32768, D, G, bx);
                    EpiStore<true> E{ws};
                    pg8::gemm_phase(lds, g, S, E);
                }
                for (int ck = 0; ck < 4; ++ck) {
                    pg8::Gemm g{(const bf16_t*)(ws + WS_AOUT) + (size_t)32768 * D + ck * 256, (const bf16_t*)(wb + WO_OUT) + ck * 256, 256, D, 256, D, D, 32768};
                    pg8::StaticOrder S; S.init(256, D, G, (bx - 4 * ck + G) % G);
                    EpiPart E{ws, (float*)(ws + WS_PARTO) + (size_t)ck * 128 * D, ck < 2 ? 1 : 0};
                    pg8::gemm_phase(lds, g, S, E);
                }
              }
            } else if (s == 7) {
              if (PHON(2)) row_pass<1>(P, 23, l, 1.0f, WS_PARTO, 4, false);
            } else {
              if (PHON(2)) row_pass<1>(P, 28, l, 0.5f, WS_PARTD, 11, l == DEPTH - 1);
              if (PHON(10)) { if (l + 1 < DEPTH) wprep_layer(P, l + 1, lds); }
            }
        }
        if (ph + 1 < P.ph_hi) {
            if (P.ph_lo < 0) grid.sync();
            { XcdBarrier xb{(unsigned*)(V.wsp + WS_BAR), xb_xcc_id(), bst}; xcd_barrier(xb); }
        }
        if (REPMASK != 0 && ph > 0 && rep == 0 && ((REPMASK >> ((ph - 1) % 11)) & 1)) { rep = 1; --ph; } else rep = 0;
    }
}

extern "C" void kernel_launch(void* const* d_in, const int* in_sizes, int n_in, void* d_out, int out_size, void* d_ws, size_t ws_size, hipStream_t stream) {
    static int grid = 0;
    if (grid == 0) {
        if (n_in != 29 || ws_size < WS_END || out_size != NB * SEQ * D) { fprintf(stderr, "kernel_launch: unexpected problem (n_in %d, ws %zu, out %d)\n", n_in, ws_size, out_size); grid = -1; return; }
        int dev = 0, cus = 0, per_cu = 0;
        hipGetDevice(&dev);
        hipDeviceGetAttribute(&cus, hipDeviceAttributeMultiprocessorCount, dev);
        hipFuncSetAttribute((const void*)mega_fwd, hipFuncAttributeMaxDynamicSharedMemorySize, LDS_BYTES);
        hipOccupancyMaxActiveBlocksPerMultiprocessor(&per_cu, (const void*)mega_fwd, 512, LDS_BYTES);
        if (per_cu < 1) { fprintf(stderr, "kernel_launch: occupancy query says %d blocks per CU\n", per_cu); per_cu = 1; }
        grid = cus * 1;
        (void)hipGetLastError();
    }
    if (grid < 0) return;
    (void)hipMemsetAsync((unsigned char*)d_ws + WS_BAR, 0, XCD_BAR_WORDS * 4, stream);
    Params p{};
    for (int i = 0; i < 29; ++i) p.in[i] = (const float*)d_in[i];
    p.out = (float*)d_out; p.ws = (unsigned char*)d_ws; p.ph_lo = 0; p.ph_hi = 1 + 11 * DEPTH;
    void* args[] = {&p};
    hipError_t e = hipLaunchCooperativeKernel((const void*)mega_fwd, dim3(grid), dim3(512), args, LDS_BYTES, stream);
    if (e != hipSuccess) fprintf(stderr, "cooperative launch failed: %s (grid %d)\n", hipGetErrorString(e), grid);
}
```

```cpp
#include <hip/hip_runtime.h>
#include <hip/hip_cooperative_groups.h>
#include <cstdio>
#include <cstdint>
#include <cmath>
namespace cg = cooperative_groups;

#define DI __device__ __forceinline__
#define LAS __attribute__((address_space(3)))
typedef unsigned short bf16_t;
typedef short bf16x8 __attribute__((ext_vector_type(8)));
typedef float f32x4 __attribute__((ext_vector_type(4)));
typedef float f32x16 __attribute__((ext_vector_type(16)));
typedef unsigned u32x4 __attribute__((ext_vector_type(4)));
typedef unsigned u32x2 __attribute__((ext_vector_type(2)));
typedef float f32x2_t __attribute__((ext_vector_type(2)));
typedef __bf16 bf16x2_t __attribute__((ext_vector_type(2)));

constexpr int NB = 8, SEQ = 4096, NMETA = 16, T = 4112, TP = 4160, D = 1024, M = NB * T, MP = 33024;
constexpr int DFF = 2816, NGU = 2 * DFF, LRUW = 512, QL = 384, KVL = 256, LDZ = 1664, NIN = 1792;
constexpr int NH = 8, DQK = 96, DV = 64, NQ = 768, NKV = 1024, NCH = 129, DEPTH = 4;
constexpr float EPS = 1e-6f;
constexpr float QSCALE = 0.10206207261596575f * 1.4426950408889634f;

constexpr size_t MiB = 1u << 20;
constexpr size_t WS_RSH = 0, WS_COS = 256 * 1024, WS_SIN = 768 * 1024;
constexpr size_t WS_SSQM = 1 * MiB + 256 * 1024;
constexpr size_t WS_SSQP = 2 * MiB + 512 * 1024;
constexpr size_t WS_AAGG = 5 * MiB + 256 * 1024, WS_BAGG = 7 * MiB + 512 * 1024;
constexpr size_t WS_BAR = 9 * MiB + 896 * 1024;
constexpr size_t WS_H = 10 * MiB;
constexpr size_t WS_HB = 139 * MiB;
constexpr size_t WS_FY = 203 * MiB + 512 * 1024;
constexpr size_t WS_W = 268 * MiB;
constexpr size_t WS_ACT = 308 * MiB;
constexpr size_t WS_Z = 308 * MiB;
constexpr size_t WS_VT = 413 * MiB;
constexpr size_t WS_AOUT = 446 * MiB;
constexpr size_t WS_END = 512 * MiB;
constexpr size_t WS_PARTD = 490 * MiB;
constexpr size_t WS_PARTO = WS_Z;
constexpr size_t WS_K = WS_H + 65 * MiB, WS_Q = WS_FY;
constexpr size_t KiB = 1024;
constexpr size_t WO_GU1 = 0, WO_D1 = 11 * MiB, WO_IN = 16 * MiB + 512 * KiB, WO_UQ = 20 * MiB, WO_UKV = 20 * MiB + 640 * KiB, WO_OUT = 21 * MiB + 256 * KiB,
                 WO_GU2 = 23 * MiB + 256 * KiB, WO_D2 = 34 * MiB + 256 * KiB, WO_LRU = 39 * MiB + 768 * KiB;
static_assert(WO_LRU + 128 * KiB <= 40 * MiB, "weights fit");
constexpr size_t DO_HLOC = 0, DO_PA = 33 * MiB, DO_KR = 66 * MiB;

constexpr int LDS_BYTES = 135168;

DI int opq_s() { int z; asm volatile("s_mov_b32 %0, 0" : "=s"(z)); return z; }
DI int opq_tid() { int t = threadIdx.x; asm volatile("" : "+v"(t)); return t; }
DI float opq_zf() { float z; asm volatile("v_mov_b32 %0, 0" : "=v"(z)); return z; }
#define GAS __attribute__((address_space(1)))
template <class T> DI T* launder_g(T* p) { GAS T* g = (GAS T*)p; asm volatile("" : "+s"(g)); return (T*)g; }
DI float bf2f(bf16_t v) { return __uint_as_float(((unsigned)v) << 16); }
DI unsigned cvt_pk(float lo, float hi) { f32x2_t v = {lo, hi}; bf16x2_t b = __builtin_convertvector(v, bf16x2_t); return __builtin_bit_cast(unsigned, b); }
DI bf16_t f2bf(float x) { return (bf16_t)(cvt_pk(x, 0.f) & 0xffffu); }
DI float bflo(unsigned w) { return __uint_as_float(w << 16); }
DI float bfhi(unsigned w) { return __uint_as_float(w & 0xffff0000u); }
template <int K> DI float sx(float v) { static_assert(K >= 1 && K < 32, "xor mask"); return __int_as_float(__builtin_amdgcn_ds_swizzle(__float_as_int(v), (K << 10) | 0x1f)); }
DI float sum_x32(float v) { auto rr = __builtin_amdgcn_permlane32_swap(__float_as_uint(v), __float_as_uint(v), false, false); return __uint_as_float(rr[0]) + __uint_as_float(rr[1]); }
DI float max_x32(float v) { auto rr = __builtin_amdgcn_permlane32_swap(__float_as_uint(v), __float_as_uint(v), false, false); return fmaxf(__uint_as_float(rr[0]), __uint_as_float(rr[1])); }
DI float other_x32(float v, int hh) { auto rr = __builtin_amdgcn_permlane32_swap(__float_as_uint(v), __float_as_uint(v), false, false); return __uint_as_float(hh ? rr[0] : rr[1]); }
template <int CTRL> DI float dppx(float v) { return __int_as_float(__builtin_amdgcn_mov_dpp(__float_as_int(v), CTRL, 0xf, 0xf, true)); }
DI float wave_sum(float v) { v += dppx<0xB1>(v); v += dppx<0x4E>(v); v += dppx<0x124>(v); v += dppx<0x128>(v); v += sx<16>(v); return sum_x32(v); }
DI float sigmoidf_(float x) { return __builtin_amdgcn_rcpf(1.0f + __expf(-x)); }
DI float silu_(float x) { return x * __builtin_amdgcn_rcpf(1.0f + __expf(-x)); }
DI float gelu_tanh(float x) { const float u = 0.7978845608028654f * (x + 0.044715f * x * x * x); const float th = 1.0f - 2.0f * __builtin_amdgcn_rcpf(__expf(2.0f * u) + 1.0f); return 0.5f * x * (1.0f + th); }
DI int crow(int r, int hi) { return (r & 3) + 8 * (r >> 2) + 4 * hi; }
DI int vpos(int t) { return (t & ~12) | ((t & 4) << 1) | ((t & 8) >> 1); }
DI u32x4 pack8(f32x4 a, f32x4 b) { u32x4 w; w.x = cvt_pk(a[0], a[1]); w.y = cvt_pk(a[2], a[3]); w.z = cvt_pk(b[0], b[1]); w.w = cvt_pk(b[2], b[3]); return w; }

namespace pg8 {
constexpr int BM = 256, BK = 64, HALF = 128, HTB = HALF * BK * 2, STAGE_BYTES = 8 * HTB, NXCD = 8, WGM = 8;
DI int lds_byte(int r, int c) { const int st = (r >> 4) * 2 + (c >> 5), rr = r & 15, cc = c & 31, ob = rr * 64 + cc * 2; return st * 1024 + (ob ^ (((ob >> 9) & 1) << 5)); }
DI void stage_rc(int b, int& R, int& C) { const int st = b / 1024, sb = b % 1024, swz = sb ^ (((sb >> 9) & 1) << 5); R = (st >> 1) * 16 + swz / 64; C = (st & 1) * 32 + (swz % 64) / 2; }
DI int perm32(int rho) { const int n = rho >> 4, i = rho & 15; return 8 * (i >> 2) + 4 * n + (i & 3); }
struct Unit { int pm, pn; };
struct Gemm { const bf16_t* A; const bf16_t* Bt; int M, N, K, lda, ldb, row0; };
struct StaticOrder {
    int nM, nN, nwg, G, c;
    DI void init(int M_, int N_, int G_, int c_) { nM = M_ / BM; nN = N_ / BM; nwg = nM * nN; G = G_; c = c_; }
    DI bool next(int i, Unit& u) const {
        const long L = (long)i * G + c; if (L >= nwg) return false;
        int wgid = (int)L; { const int q = nwg / NXCD, r = nwg % NXCD, xcd = wgid % NXCD, off = wgid / NXCD; wgid = (xcd < r ? xcd * (q + 1) : r * (q + 1) + (xcd - r) * q) + off; }
        const int nig = WGM * nN, gid = wgid / nig, fm = gid * WGM, gsz = (nM - fm) < WGM ? (nM - fm) : WGM;
        u.pm = fm + ((wgid % nig) % gsz); u.pn = (wgid % nig) / gsz; return true;
    }
};
template <class Epi, class Sched>
DI void gemm_phase(LAS unsigned char* lds, const Gemm g, const Sched& S, const Epi& E) {
    const int tid = opq_tid(), wid = __builtin_amdgcn_readfirstlane(tid >> 6), lane = tid & 63, wr = wid >> 2, wc = wid & 3, fr = lane & 15, fq = lane >> 4;
    int K = g.K; asm volatile("" : "+s"(K));
    const int nt = K / BK;
    unsigned voffA[2], voffB[2];
#pragma unroll
    for (int i = 0; i < 2; ++i) { int R, C; stage_rc(tid * 16 + i * 8192, R, C); const int Rb = (R & ~31) + perm32(R & 31);
        voffA[i] = (unsigned)(R * g.lda + C) * 2u; voffB[i] = (unsigned)(Rb * g.ldb + C) * 2u; }
    const size_t kstep = (size_t)(BK * 2);
    const size_t hstepA = (size_t)HALF * g.lda * 2, hstepB = (size_t)HALF * g.ldb * 2;
    const size_t tstepA = 2 * hstepA, tstepB = 2 * hstepB;
    const unsigned ldsw = (unsigned)wid * 1024u;
    const int aoff = lds_byte(wr * 64 + fr, fq * 8), boff = lds_byte(wc * 32 + fr, fq * 8);
#define PG8_SA(b, h) (((b) * 2 + (h)) * HTB)
#define PG8_SB(b, h) ((4 + (b) * 2 + (h)) * HTB)
#define PG8_STAGE(bufoff, gbase, voff) do { _Pragma("unroll") for (int _i = 0; _i < 2; ++_i) \
        __builtin_amdgcn_global_load_lds((const unsigned*)((const char*)(gbase) + (voff)[_i]), (LAS unsigned*)(lds + (bufoff) + ldsw + _i * 8192), 16, 0, 0); } while (0)
#define PG8_LDA(dst, b, h) do { _Pragma("unroll") for (int m = 0; m < 4; ++m) _Pragma("unroll") for (int k = 0; k < 2; ++k) dst[m][k] = *(const LAS bf16x8*)(lds + PG8_SA(b, h) + aoff + m * 2048 + k * 1024); } while (0)
#define PG8_LDB(dst, b, h) do { _Pragma("unroll") for (int n = 0; n < 2; ++n) _Pragma("unroll") for (int k = 0; k < 2; ++k) dst[n][k] = *(const LAS bf16x8*)(lds + PG8_SB(b, h) + boff + n * 2048 + k * 1024); } while (0)
#define PG8_MMA(ai, bj, At, Bt) do { __builtin_amdgcn_s_setprio(1); _Pragma("unroll") for (int m = 0; m < 4; ++m) _Pragma("unroll") for (int n = 0; n < 2; ++n) _Pragma("unroll") for (int k = 0; k < 2; ++k) \
        acc[ai][bj][m][n] = __builtin_amdgcn_mfma_f32_16x16x32_bf16(Bt[n][k], At[m][k], acc[ai][bj][m][n], 0, 0, 0); __builtin_amdgcn_s_setprio(0); } while (0)
#define PG8_WAIT_V(n) asm volatile("s_waitcnt vmcnt(" #n ")" ::: "memory")
#define PG8_WAIT_L(n) asm volatile("s_waitcnt lgkmcnt(" #n ")" ::: "memory")
#define PG8_BAR __builtin_amdgcn_s_barrier()
#define PG8_SCHED __builtin_amdgcn_sched_barrier(0)
    Unit cur, nxt; int ui = 0;
    if (!S.next(0, cur)) return;
    f32x4 acc[2][2][4][2];
#pragma unroll
    for (int a = 0; a < 2; ++a)
#pragma unroll
        for (int b = 0; b < 2; ++b)
#pragma unroll
            for (int m = 0; m < 4; ++m)
#pragma unroll
                for (int n = 0; n < 2; ++n) acc[a][b][m][n] = (f32x4){0.f, 0.f, 0.f, 0.f};
    bf16x8 At[4][2], B0[2][2], B1[2][2];
    const char* cA = (const char*)g.A + (size_t)cur.pm * tstepA; const char* cB = (const char*)g.Bt + (size_t)cur.pn * tstepB;
    PG8_STAGE(PG8_SB(0, 0), cB, voffB); PG8_STAGE(PG8_SB(0, 1), cB + hstepB, voffB); PG8_STAGE(PG8_SA(0, 0), cA, voffA); PG8_STAGE(PG8_SA(0, 1), cA + hstepA, voffA);
    if (wr == 1) PG8_BAR;
    PG8_WAIT_V(2); PG8_BAR;
    PG8_STAGE(PG8_SB(1, 0), cB + kstep, voffB); PG8_STAGE(PG8_SA(1, 0), cA + kstep, voffA); PG8_STAGE(PG8_SB(1, 1), cB + hstepB + kstep, voffB);
    PG8_WAIT_V(6); PG8_BAR;
    for (;;) {
        const bool has_next = S.next(ui + 1, nxt);
        const char* nA = has_next ? (const char*)g.A + (size_t)nxt.pm * tstepA : cA; const char* nB = has_next ? (const char*)g.Bt + (size_t)nxt.pn * tstepB : cB;
        float pf[8];
#pragma unroll
        for (int q = 0; q < 8; ++q) pf[q] = 0.f;
        E.prefetch(pf, cur, wr, fr);
        const bool full = (g.row0 + cur.pm * BM + HALF) < 32896;
        for (int t = 0; t < nt; t += 2) {
            const bool last = (t == nt - 2);
            if constexpr (Epi::MIDSCALE) { if (t == (nt >> 1)) { int wr_ = wr, wc_ = wc, fr_ = fr, fq_ = fq; asm volatile("" : "+s"(wr_), "+s"(wc_), "+v"(fr_), "+v"(fq_)); E.midscale(acc, cur, wr_, wc_, fr_, fq_); } }
            const char* a1 = cA + (size_t)(t + 1) * kstep;
            const char* a2 = last ? nA : cA + (size_t)(t + 2) * kstep; const char* b2 = last ? nB : cB + (size_t)(t + 2) * kstep;
            const char* a3 = a2 + kstep; const char* b3 = b2 + kstep;
            PG8_LDB(B0, 0, 0); PG8_LDB(B1, 0, 1); PG8_SCHED; PG8_LDA(At, 0, 0); PG8_STAGE(PG8_SA(1, 1), a1 + hstepA, voffA);
            PG8_WAIT_V(8); PG8_WAIT_L(0); PG8_BAR; PG8_MMA(0, 0, At, B0); PG8_MMA(0, 1, At, B1); PG8_BAR; PG8_SCHED;
            PG8_LDA(At, 0, 1); PG8_STAGE(PG8_SB(0, 0), b2, voffB); PG8_STAGE(PG8_SB(0, 1), b2 + hstepB, voffB); PG8_STAGE(PG8_SA(0, 0), a2, voffA);
            PG8_WAIT_V(8); PG8_WAIT_L(0); PG8_BAR; if (full) { PG8_MMA(1, 0, At, B0); PG8_MMA(1, 1, At, B1); } PG8_BAR; PG8_SCHED;
            PG8_LDB(B0, 1, 0); PG8_LDB(B1, 1, 1); PG8_SCHED; PG8_LDA(At, 1, 0); PG8_STAGE(PG8_SA(0, 1), a2 + hstepA, voffA);
            PG8_WAIT_V(8); PG8_WAIT_L(0); PG8_BAR; PG8_MMA(0, 0, At, B0); PG8_MMA(0, 1, At, B1); PG8_BAR; PG8_SCHED;
            PG8_LDA(At, 1, 1); PG8_STAGE(PG8_SB(1, 0), b3, voffB); PG8_STAGE(PG8_SB(1, 1), b3 + hstepB, voffB); PG8_STAGE(PG8_SA(1, 0), a3, voffA);
            PG8_WAIT_V(8); PG8_WAIT_L(0); PG8_BAR; if (full) { PG8_MMA(1, 0, At, B0); PG8_MMA(1, 1, At, B1); } PG8_BAR; PG8_SCHED;
        }
        if (wr == 0) PG8_BAR;
        { int wr_ = wr, wc_ = wc, fr_ = fr, fq_ = fq; asm volatile("" : "+s"(wr_), "+s"(wc_), "+v"(fr_), "+v"(fq_)); E(acc, cur, wr_, wc_, fr_, fq_, pf); }
        if (!has_next) break;
#pragma unroll
        for (int a = 0; a < 2; ++a)
#pragma unroll
            for (int b = 0; b < 2; ++b)
#pragma unroll
                for (int m = 0; m < 4; ++m)
#pragma unroll
                    for (int n = 0; n < 2; ++n) acc[a][b][m][n] = (f32x4){0.f, 0.f, 0.f, 0.f};
        cur = nxt; cA = nA; cB = nB; ++ui;
        if (wr == 1) PG8_BAR;
    }
    PG8_WAIT_V(0);
    PG8_BAR;
#undef PG8_SA
#undef PG8_SB
#undef PG8_STAGE
#undef PG8_LDA
#undef PG8_LDB
#undef PG8_MMA
#undef PG8_WAIT_V
#undef PG8_WAIT_L
#undef PG8_BAR
#undef PG8_SCHED
}
}
using pg8::Unit;
typedef f32x4 Acc[2][2][4][2];

struct EpiGU {
    static constexpr bool MIDSCALE = false;
    unsigned char* ws;
    DI void midscale(Acc&, const Unit&, int, int, int, int) const {}
    DI void prefetch(float (&pf)[8], const Unit& u, int wr, int fr) const {
        const float* rs = (const float*)(launder_g(ws) + WS_RSH);
#pragma unroll
        for (int q = 0; q < 8; ++q) pf[q] = rs[u.pm * 256 + (q >> 2) * 128 + wr * 64 + (q & 3) * 16 + fr];
    }
    DI void operator()(const Acc& acc, const Unit& u, int wr, int wc, int fr, int fq, const float (&pf)[8]) const {
        unsigned char* w = launder_g(ws);
        bf16_t* O = (bf16_t*)(w + WS_ACT); const float* rs = (const float*)(w + WS_RSH);
#pragma unroll
        for (int ai = 0; ai < 2; ++ai)
#pragma unroll
            for (int m = 0; m < 4; ++m) {
                const int row = u.pm * 256 + ai * 128 + wr * 64 + m * 16 + fr;
                const float s = pf[ai * 4 + m];
                f32x4 o0, o1;
#pragma unroll
                for (int j = 0; j < 4; ++j) { o0[j] = silu_(acc[ai][0][m][0][j] * s) * (acc[ai][1][m][0][j] * s); o1[j] = silu_(acc[ai][0][m][1][j] * s) * (acc[ai][1][m][1][j] * s); }
                *(u32x4*)(O + (size_t)row * DFF + u.pn * 128 + wc * 32 + 8 * fq) = pack8(o0, o1);
            }
    }
};
template <bool MID> struct EpiStore {
    static constexpr bool MIDSCALE = MID;
    unsigned char* ws;
    DI void prefetch(float (&pf)[8], const Unit&, int, int) const { (void)pf; }
    DI void midscale(Acc& acc, const Unit& u, int wr, int wc, int fr, int fq) const {
        unsigned char* w = launder_g(ws);
        const float* ssq = (const float*)(w + WS_SSQM);
#pragma unroll
        for (int ai = 0; ai < 2; ++ai)
#pragma unroll
            for (int m = 0; m < 4; ++m) {
                const int row = u.pm * 256 + ai * 128 + wr * 64 + m * 16 + fr;
                const f32x4 sa = *(const f32x4*)(ssq + (size_t)row * 8), sb = *(const f32x4*)(ssq + (size_t)row * 8 + 4);
                const float s = rsqrtf((((sa[0] + sa[1]) + (sa[2] + sa[3])) + ((sb[0] + sb[1]) + (sb[2] + sb[3]))) * (1.0f / 512.0f) + EPS);
#pragma unroll
                for (int bj = 0; bj < 2; ++bj)
#pragma unroll
                    for (int n = 0; n < 2; ++n) acc[ai][bj][m][n] = acc[ai][bj][m][n] * s;
            }
    }
    DI void operator()(const Acc& acc, const Unit& u, int wr, int wc, int fr, int fq, const float (&pf)[8]) const {
        unsigned char* w = launder_g(ws);
        bf16_t* O = (bf16_t*)(w + WS_FY);
#pragma unroll
        for (int ai = 0; ai < 2; ++ai)
#pragma unroll
            for (int m = 0; m < 4; ++m) {
                const int row = u.pm * 256 + ai * 128 + wr * 64 + m * 16 + fr;
#pragma unroll
                for (int bj = 0; bj < 2; ++bj)
                    *(u32x4*)(O + (size_t)row * D + u.pn * 256 + bj * 128 + wc * 32 + 8 * fq) = pack8(acc[ai][bj][m][0], acc[ai][bj][m][1]);
            }
    }
};
struct EpiPart {
    static constexpr bool MIDSCALE = false;
    unsigned char* ws; float* part; int scale_mla;
    DI void midscale(Acc&, const Unit&, int, int, int, int) const {}
    DI void prefetch(float (&pf)[8], const Unit&, int, int) const { (void)pf; }
    DI void operator()(const Acc& acc, const Unit& u, int wr, int wc, int fr, int fq, const float (&pf)[8]) const {
        unsigned char* w = launder_g(ws); float* pp = launder_g(part);
        const float* ssq = (const float*)(w + WS_SSQM);
#pragma unroll
        for (int m = 0; m < 4; ++m) {
            const int rl = wr * 64 + m * 16 + fr;
            float s = 1.0f;
            if (scale_mla) { const size_t row = 32768 + rl; const f32x4 sa = *(const f32x4*)(ssq + row * 8), sb = *(const f32x4*)(ssq + row * 8 + 4);
                s = rsqrtf((((sa[0] + sa[1]) + (sa[2] + sa[3])) + ((sb[0] + sb[1]) + (sb[2] + sb[3]))) * (1.0f / 512.0f) + EPS); }
#pragma unroll
            for (int bj = 0; bj < 2; ++bj) {
                float* d = pp + (size_t)rl * D + u.pn * 256 + bj * 128 + wc * 32 + 8 * fq;
                *(f32x4*)d = acc[0][bj][m][0] * s; *(f32x4*)(d + 4) = acc[0][bj][m][1] * s;
            }
        }
    }
};
struct EpiIn {
    static constexpr bool MIDSCALE = false;
    unsigned char* ws; unsigned char* dout;
    DI void midscale(Acc&, const Unit&, int, int, int, int) const {}
    DI void prefetch(float (&pf)[8], const Unit& u, int wr, int fr) const {
        const float* rs = (const float*)(launder_g(ws) + WS_RSH);
#pragma unroll
        for (int q = 0; q < 8; ++q) pf[q] = rs[u.pm * 256 + (q >> 2) * 128 + wr * 64 + (q & 3) * 16 + fr];
    }
    DI void operator()(const Acc& acc, const Unit& u, int wr, int wc, int fr, int fq, const float (&pf)[8]) const {
        unsigned char* w = launder_g(ws); unsigned char* dq = launder_g(dout);
        bf16_t* Z = (bf16_t*)(w + WS_Z); bf16_t* KR = (bf16_t*)(dq + DO_KR); const float* rs = (const float*)(w + WS_RSH);
        float* ssqp = (float*)(w + WS_SSQP); const float* cosT = (const float*)(w + WS_COS); const float* sinT = (const float*)(w + WS_SIN);
#pragma unroll
        for (int ai = 0; ai < 2; ++ai)
#pragma unroll
            for (int m = 0; m < 4; ++m) {
                const int row = u.pm * 256 + ai * 128 + wr * 64 + m * 16 + fr;
                const float s = pf[ai * 4 + m];
#pragma unroll
                for (int bj = 0; bj < 2; ++bj) {
                    const int cb = u.pn * 256 + bj * 128 + wc * 32;
                    const int col = cb + 8 * fq;
                    const f32x4 v0 = acc[ai][bj][m][0] * s, v1 = acc[ai][bj][m][1] * s;
                    if (cb < LDZ) {
                        *(u32x4*)(Z + (size_t)row * LDZ + col) = pack8(v0, v1);
                        if (cb >= 1024) {
                            float q = (v0[0] * v0[0] + v0[1] * v0[1]) + (v0[2] * v0[2] + v0[3] * v0[3]) + (v1[0] * v1[0] + v1[1] * v1[1]) + (v1[2] * v1[2] + v1[3] * v1[3]);
                            q += sx<16>(q); q = sum_x32(q);
                            if (fq == 0 && row < M) ssqp[(size_t)row * 20 + ((cb - 1024) >> 5)] = q;
                        }
                    } else if (cb == LDZ) {
                        if (row < M) {
                            const int t = row % T;
                            const f32x4 c = *(const f32x4*)(cosT + t * 16 + 4 * fq), sn = *(const f32x4*)(sinT + t * 16 + 4 * fq);
                            const f32x4 o1 = v0 * c - v1 * sn, o2 = v1 * c + v0 * sn;
                            *(u32x4*)(KR + (size_t)row * 32 + 8 * fq) = pack8(o1, o2);
                        }
                    }
                }
            }
    }
};
struct EpiQ {
    static constexpr bool MIDSCALE = false;
    unsigned char* ws;
    DI void midscale(Acc&, const Unit&, int, int, int, int) const {}
    DI void prefetch(float (&pf)[8], const Unit&, int, int) const { (void)pf; }
    DI void operator()(const Acc& acc, const Unit& u, int wr, int wc, int fr, int fq, const float (&pf)[8]) const {
        unsigned char* w = launder_g(ws);
        bf16_t* Q = (bf16_t*)(w + WS_Q); const float* ssqp = (const float*)(w + WS_SSQP); const float* cosT = (const float*)(w + WS_COS); const float* sinT = (const float*)(w + WS_SIN);
#pragma unroll
        for (int ai = 0; ai < 2; ++ai)
#pragma unroll
            for (int m = 0; m < 4; ++m) {
                const int row = u.pm * 256 + ai * 128 + wr * 64 + m * 16 + fr;
                if (row < M) {
                    const int b = row / T, t = row - b * T;
                    const f32x4 sa = *(const f32x4*)(ssqp + (size_t)row * 20), sb = *(const f32x4*)(ssqp + (size_t)row * 20 + 4), sc = *(const f32x4*)(ssqp + (size_t)row * 20 + 8);
                    const float ssq = ((sa[0] + sa[1]) + (sa[2] + sa[3])) + ((sb[0] + sb[1]) + (sb[2] + sb[3])) + ((sc[0] + sc[1]) + (sc[2] + sc[3]));
                    const float s = rsqrtf(ssq * (1.0f / 384.0f) + EPS) * QSCALE;
#pragma unroll
                    for (int bj = 0; bj < 2; ++bj) {
                        const int col = u.pn * 256 + bj * 128 + wc * 32 + 8 * fq;
                        const int hd = col / 96, dd = col - hd * 96;
                        f32x4 v0 = acc[ai][bj][m][0] * s, v1 = acc[ai][bj][m][1] * s;
                        if (dd >= 64) {
                            const int g = (dd - 64) >> 3;
                            const f32x4 c = *(const f32x4*)(cosT + t * 16 + 4 * g), sn = *(const f32x4*)(sinT + t * 16 + 4 * g);
                            const f32x4 o1 = v0 * c - v1 * sn, o2 = v1 * c + v0 * sn; v0 = o1; v1 = o2;
                        }
                        *(u32x4*)(Q + ((size_t)(b * NH + hd) * TP + t) * DQK + dd) = pack8(v0, v1);
                    }
                }
            }
    }
};
struct EpiKV {
    static constexpr bool MIDSCALE = false;
    unsigned char* ws; unsigned char* dout;
    DI void midscale(Acc&, const Unit&, int, int, int, int) const {}
    DI void prefetch(float (&pf)[8], const Unit&, int, int) const { (void)pf; }
    DI void operator()(const Acc& acc, const Unit& u, int wr, int wc, int fr, int fq, const float (&pf)[8]) const {
        unsigned char* w = launder_g(ws); unsigned char* dq = launder_g(dout);
        bf16_t* Kb = (bf16_t*)(w + WS_K); bf16_t* Vt = (bf16_t*)(w + WS_VT); const bf16_t* KR = (const bf16_t*)(dq + DO_KR); const float* ssqp = (const float*)(w + WS_SSQP);
#pragma unroll
        for (int ai = 0; ai < 2; ++ai)
#pragma unroll
            for (int m = 0; m < 4; ++m) {
                const int row = u.pm * 256 + ai * 128 + wr * 64 + m * 16 + fr;
                if (row < M) {
                    const int b = row / T, t = row - b * T;
                    const f32x4 sa = *(const f32x4*)(ssqp + (size_t)row * 20 + 12), sb = *(const f32x4*)(ssqp + (size_t)row * 20 + 16);
                    const float ssq = ((sa[0] + sa[1]) + (sa[2] + sa[3])) + ((sb[0] + sb[1]) + (sb[2] + sb[3]));
                    const float s = rsqrtf(ssq * (1.0f / 256.0f) + EPS);
#pragma unroll
                    for (int bj = 0; bj < 2; ++bj) {
                        const int hd = u.pn * 2 + bj;
                        const f32x4 v0 = acc[ai][bj][m][0] * s, v1 = acc[ai][bj][m][1] * s;
                        bf16_t* krow = Kb + ((size_t)(b * NH + hd) * TP + t) * DQK;
                        if (wc < 2) {
                            *(u32x4*)(krow + wc * 32 + 8 * fq) = pack8(v0, v1);
                        } else {
                            const int d0 = (wc - 2) * 32 + 8 * fq;
                            bf16_t* vp = Vt + ((size_t)(b * NH + hd) * DV + d0) * TP + vpos(t);
#pragma unroll
                            for (int j = 0; j < 4; ++j) { vp[(size_t)j * TP] = f2bf(v0[j]); vp[(size_t)(4 + j) * TP] = f2bf(v1[j]); }
                            if (wc == 2) *(u32x4*)(krow + 64 + 8 * fq) = *(const u32x4*)(KR + (size_t)row * 32 + 8 * fq);
                        }
                    }
                }
            }
    }
};

struct Params { const float* in[29]; float* out; unsigned char* ws; int ph_lo, ph_hi; };
struct PV { const Params& P; int z; int tid; int bx; int G; unsigned char* wsp; float* outp;
    DI const float* in(int k) const { return (const float*)(const GAS float*)P.in[k + z]; }
    DI unsigned char* ws() const { return wsp; }
    DI float* out() const { return outp; } };
DI PV mkpv(const Params& P) {
    int z = opq_s(); int tid = opq_tid(); int bx = blockIdx.x; int G = gridDim.x; unsigned char* w = launder_g(P.ws); float* o = launder_g(P.out);
    asm volatile("" : "+s"(bx)); asm volatile("" : "+s"(G));
    return PV{P, z, tid, bx, G, w, o};
}
#define MKPV(P) mkpv(P)

template <class CM>
DI void wprep_item(const CM cm, int it, int ldsrc, bf16_t* Bt, int Nrows, int ldb, int dst_k0, const float* kscale, LAS float* scr, int lane) {
    const int nblk = Nrows / 32;
    const int kb = it / nblk, nb = it - kb * nblk, k0 = 64 * kb, n0 = 32 * nb;
    const float* sp = cm(n0 + (lane & 31));
#pragma unroll
    for (int i = 0; i < 32; ++i) { const int kk = 2 * i + (lane >> 5); float v = 0.f; if (sp) { v = __builtin_nontemporal_load(sp + (size_t)(k0 + kk) * ldsrc); if (kscale) v *= kscale[k0 + kk]; } scr[kk * 33 + (lane & 31)] = v; }
    asm volatile("s_waitcnt lgkmcnt(0)" ::: "memory");
    const int c = lane & 7;
#pragma unroll
    for (int j = 0; j < 4; ++j) { const int n = (lane >> 3) + 8 * j; const LAS float* s = scr + (8 * c) * 33 + n;
        u32x4 o; o.x = cvt_pk(s[0 * 33], s[1 * 33]); o.y = cvt_pk(s[2 * 33], s[3 * 33]); o.z = cvt_pk(s[4 * 33], s[5 * 33]); o.w = cvt_pk(s[6 * 33], s[7 * 33]);
        *(u32x4*)(Bt + (size_t)(n0 + n) * ldb + dst_k0 + k0 + 8 * c) = o; }
    asm volatile("s_waitcnt lgkmcnt(0)" ::: "memory");
}
struct CMPlain { const float* W; DI const float* operator()(int p) const { return W + p; } };
struct CMGateUp { const float* Wg; const float* Wu; DI const float* operator()(int p) const { const int tile = p >> 8, w = p & 255; const long d = (w < 128) ? 0 : (long)(Wu - Wg); return Wg + d + tile * 128 + (w & 127); } };
DI int rope_src(int pp) { const int g = pp >> 3, e = pp & 7; return (e < 4) ? (4 * g + e) : (16 + 4 * g + (e - 4)); }
struct CMIn { const float* W; DI const float* operator()(int p) const { if (p < 1664) return W + p; if (p < 1696) return W + 1664 + rope_src(p - 1664); return nullptr; } };
struct CMQ { const float* W; DI const float* operator()(int p) const { const int hd = p / 96, dd = p - hd * 96; return W + hd * 96 + (dd < 64 ? dd : 64 + rope_src(dd - 64)); } };

DI void wprep_layer(const Params& P0, int l, LAS unsigned char* lds) {
    const PV P = MKPV(P0);
    const int lane = P.tid & 63, wid = P.tid >> 6;
    const int gw = P.bx * 8 + wid, NGW = P.G * 8;
    LAS float* scr = (LAS float*)(lds + wid * 8704);
    unsigned char* wb = P.ws() + WS_W;
    const size_t ffw = (size_t)D * DFF;
    constexpr int I_GU = (D / 64) * (NGU / 32), I_D = (DFF / 64) * (D / 32), I_IN = (D / 64) * (NIN / 32), I_UQ = (QL / 64) * (NQ / 32), I_UKV = (KVL / 64) * (NKV / 32),
                  I_O = (512 / 64) * (D / 32), I_LRU = 32;
    constexpr int E0 = I_GU, E1 = E0 + I_D, E2 = E1 + I_GU, E3 = E2 + I_D, E4 = E3 + I_IN, E5 = E4 + I_O, E6 = E5 + I_O, E7 = E6 + I_UQ, E8 = E7 + I_UKV, E9 = E8 + I_LRU;
    for (int it = gw; it < E9; it += NGW) {
        if (it < E0) wprep_item(CMGateUp{P.in(3) + l * ffw, P.in(4) + l * ffw}, it, DFF, (bf16_t*)(wb + WO_GU1), NGU, D, 0, P.in(2) + l * D, scr, lane);
        else if (it < E1) wprep_item(CMPlain{P.in(5) + l * ffw}, it - E0, D, (bf16_t*)(wb + WO_D1), D, DFF, 0, nullptr, scr, lane);
        else if (it < E2) wprep_item(CMGateUp{P.in(25) + l * ffw, P.in(26) + l * ffw}, it - E1, DFF, (bf16_t*)(wb + WO_GU2), NGU, D, 0, P.in(24) + l * D, scr, lane);
        else if (it < E3) wprep_item(CMPlain{P.in(27) + l * ffw}, it - E2, D, (bf16_t*)(wb + WO_D2), D, DFF, 0, nullptr, scr, lane);
        else if (it < E4) wprep_item(CMIn{P.in(8) + (size_t)l * D * 1696}, it - E3, 1696, (bf16_t*)(wb + WO_IN), NIN, D, 0, P.in(7) + l * D, scr, lane);
        else if (it < E5) wprep_item(CMPlain{P.in(22) + (size_t)l * D * D + (size_t)512 * D}, it - E4, D, (bf16_t*)(wb + WO_OUT), D, D, 0, P.in(21) + l * 512, scr, lane);
        else if (it < E6) wprep_item(CMPlain{P.in(22) + (size_t)l * D * D}, it - E5, D, (bf16_t*)(wb + WO_OUT), D, D, 512, nullptr, scr, lane);
        else if (it < E7) wprep_item(CMQ{P.in(17) + (size_t)l * QL * NQ}, it - E6, NQ, (bf16_t*)(wb + WO_UQ), NQ, QL, 0, P.in(16) + l * QL, scr, lane);
        else if (it < E8) wprep_item(CMPlain{P.in(19) + (size_t)l * KVL * NKV}, it - E7, NKV, (bf16_t*)(wb + WO_UKV), NKV, KVL, 0, P.in(18) + l * KVL, scr, lane);
        else {
            const int r = it - E8, q = r >> 1, hd = q >> 1, mat = q & 1;
            wprep_item(CMPlain{P.in(mat ? 13 : 11) + (size_t)l * 8 * 4096 + hd * 4096}, r & 1, 64, (bf16_t*)(wb + WO_LRU) + (size_t)q * 4096, 64, 64, 0, nullptr, scr, lane);
        }
    }
}

DI void unpack8(const u32x4 w, f32x4& a, f32x4& b) { a = (f32x4){bflo(w.x), bfhi(w.x), bflo(w.y), bfhi(w.y)}; b = (f32x4){bflo(w.z), bfhi(w.z), bflo(w.w), bfhi(w.w)}; }
DI float lo_dec1(unsigned hb16, int q) { return __uint_as_float((hb16 << 16) + (unsigned)(q << 8)); }
DI unsigned lo_enc1(float h, unsigned hb16) {
    int qi = ((int)(__float_as_uint(h) - (hb16 << 16)) + 128) >> 8;
    qi = qi > 127 ? 127 : qi;
    return (unsigned)qi & 0xFFu;
}
DI void lo_dec8(const u32x4 hw, const u32x2 lw, f32x4& a, f32x4& b) {
    const unsigned w[4] = {hw.x, hw.y, hw.z, hw.w};
#pragma unroll
    for (int k = 0; k < 4; ++k) {
        a[k] = lo_dec1((k & 1) ? (w[k >> 1] >> 16) : (w[k >> 1] & 0xFFFFu), (int)(lw.x << (24 - 8 * k)) >> 24);
        b[k] = lo_dec1((k & 1) ? (w[2 + (k >> 1)] >> 16) : (w[2 + (k >> 1)] & 0xFFFFu), (int)(lw.y << (24 - 8 * k)) >> 24);
    }
}
DI u32x2 lo_enc8(const f32x4 a, const f32x4 b, const u32x4 hw) {
    const unsigned w[4] = {hw.x, hw.y, hw.z, hw.w};
    u32x2 r; r.x = 0u; r.y = 0u;
#pragma unroll
    for (int k = 0; k < 4; ++k) {
        r.x |= lo_enc1(a[k], (k & 1) ? (w[k >> 1] >> 16) : (w[k >> 1] & 0xFFFFu)) << (8 * k);
        r.y |= lo_enc1(b[k], (k & 1) ? (w[2 + (k >> 1)] >> 16) : (w[2 + (k >> 1)] & 0xFFFFu)) << (8 * k);
    }
    return r;
}
template <int MODE>
DI void row_pass(const Params& P0, int gain_idx, int l, float coef, size_t part_off, int nchunk, bool final_out) {
    const PV P = MKPV(P0);
    const int lane = P.tid & 63, wid = P.tid >> 6;
    const int gw = P.bx * 8 + wid, NGW = P.G * 8;
    unsigned char* LO = (unsigned char*)(P.ws() + WS_H); bf16_t* HB = (bf16_t*)(P.ws() + WS_HB); const bf16_t* FY = (const bf16_t*)(P.ws() + WS_FY);
    float* rsh = (float*)(P.ws() + WS_RSH);
    constexpr int R = 4;
    f32x4 gv[4];
    if (MODE == 1) { const f32x4* gp = (const f32x4*)(P.in(gain_idx) + l * D); gv[0] = gp[2 * lane]; gv[1] = gp[2 * lane + 1]; gv[2] = gp[128 + 2 * lane]; gv[3] = gp[129 + 2 * lane]; }
    const float* PART = (const float*)(P.ws() + part_off);
    for (int row0 = gw; row0 < M; row0 += R * NGW) {
        f32x4 hv[R][4]; u32x4 f0[R], f1[R], h0[R], h1[R]; u32x2 l0[R], l1[R];
#pragma unroll
        for (int q = 0; q < R; ++q) {
            const int row = row0 + q * NGW;
            if (row < M) {
                if (MODE == 0) {
                    const int b = row / T, t = row - b * T;
                    const f32x4* sp = (const f32x4*)((t < NMETA) ? (P.in(1) + (size_t)t * D) : (P.in(0) + ((size_t)b * SEQ + (t - NMETA)) * D));
                    hv[q][0] = __builtin_nontemporal_load(sp + 2 * lane); hv[q][1] = __builtin_nontemporal_load(sp + 2 * lane + 1); hv[q][2] = __builtin_nontemporal_load(sp + 128 + 2 * lane); hv[q][3] = __builtin_nontemporal_load(sp + 129 + 2 * lane);
                } else {
                    if (row < 32768) { const u32x4* fp = (const u32x4*)(FY + (size_t)row * D); f0[q] = fp[lane]; f1[q] = fp[64 + lane]; }
                    else {
                        f32x4 a0 = (f32x4){0.f, 0.f, 0.f, 0.f}, a1 = a0, a2 = a0, a3 = a0;
                        for (int c = 0; c < nchunk; ++c) { const f32x4* pp = (const f32x4*)(PART + ((size_t)c * 128 + (row - 32768)) * D); a0 += pp[2 * lane]; a1 += pp[2 * lane + 1]; a2 += pp[128 + 2 * lane]; a3 += pp[129 + 2 * lane]; }
                        f0[q] = pack8(a0, a1); f1[q] = pack8(a2, a3);
                    }
                    const u32x4* hp = (const u32x4*)(HB + (size_t)row * D); h0[q] = __builtin_nontemporal_load(hp + lane); h1[q] = __builtin_nontemporal_load(hp + 64 + lane);
                    const u32x2* lp = (const u32x2*)(LO + (size_t)row * D); l0[q] = __builtin_nontemporal_load(lp + lane); l1[q] = __builtin_nontemporal_load(lp + 64 + lane);
                }
            }
        }
#pragma unroll
        for (int q = 0; q < R; ++q) {
            const int row = row0 + q * NGW;
            if (row < M) {
                const int b = row / T, t = row - b * T;
                if (MODE == 1) {
                    f32x4 fv[4];
                    unpack8(f0[q], fv[0], fv[1]); unpack8(f1[q], fv[2], fv[3]);
                    lo_dec8(h0[q], l0[q], hv[q][0], hv[q][1]); lo_dec8(h1[q], l1[q], hv[q][2], hv[q][3]);
                    float ss = 0.f;
#pragma unroll
                    for (int j = 0; j < 4; ++j) ss += (fv[j][0] * fv[j][0] + fv[j][1] * fv[j][1]) + (fv[j][2] * fv[j][2] + fv[j][3] * fv[j][3]);
                    ss = wave_sum(ss);
                    const float rn = rsqrtf(ss * (1.0f / D) + EPS) * coef;
#pragma unroll
                    for (int j = 0; j < 4; ++j) hv[q][j] = hv[q][j] + fv[j] * rn * gv[j];
                }
                if (final_out) {
                    if (t >= NMETA) {
                        f32x4* op = (f32x4*)(P.out() + ((size_t)b * SEQ + (t - NMETA)) * D);
                        __builtin_nontemporal_store(hv[q][0], op + 2 * lane); __builtin_nontemporal_store(hv[q][1], op + 2 * lane + 1); __builtin_nontemporal_store(hv[q][2], op + 128 + 2 * lane); __builtin_nontemporal_store(hv[q][3], op + 129 + 2 * lane);
                    }
                } else {
                    float s2 = 0.f;
#pragma unroll
                    for (int j = 0; j < 4; ++j) s2 += (hv[q][j][0] * hv[q][j][0] + hv[q][j][1] * hv[q][j][1]) + (hv[q][j][2] * hv[q][j][2] + hv[q][j][3] * hv[q][j][3]);
                    s2 = wave_sum(s2);
                    const u32x4 hb0 = pack8(hv[q][0], hv[q][1]), hb1 = pack8(hv[q][2], hv[q][3]);
                    u32x4* bp = (u32x4*)(HB + (size_t)row * D); bp[lane] = hb0; bp[64 + lane] = hb1;
                    u32x2* lp = (u32x2*)(LO + (size_t)row * D); __builtin_nontemporal_store(lo_enc8(hv[q][0], hv[q][1], hb0), lp + lane); __builtin_nontemporal_store(lo_enc8(hv[q][2], hv[q][3], hb1), lp + 64 + lane);
                    if (lane == 0) rsh[row] = rsqrtf(s2 * (1.0f / D) + EPS);
                }
            }
        }
    }
}

DI void lru_local(const Params& P0, int l, LAS unsigned char* lds) {
    const PV P = MKPV(P0);
    const int tid = P.tid, lane = tid & 63, wid = tid >> 6, r = lane & 31, hh = lane >> 5;
    const bf16_t* Z = (const bf16_t*)(P.ws() + WS_Z);
    const bf16_t* LW = (const bf16_t*)(P.ws() + WS_W + WO_LRU);
    bf16_t* HLOC = (bf16_t*)((unsigned char*)P.out() + DO_HLOC); bf16_t* PA = (bf16_t*)((unsigned char*)P.out() + DO_PA);
    float* AAGG = (float*)(P.ws() + WS_AAGG); float* BAGG = (float*)(P.ws() + WS_BAGG);
    LAS bf16_t* xcs = (LAS bf16_t*)lds;
    bf16x8 wf[2][2][4];
#pragma unroll
    for (int mat = 0; mat < 2; ++mat)
#pragma unroll
        for (int nb = 0; nb < 2; ++nb)
#pragma unroll
            for (int s = 0; s < 4; ++s) wf[mat][nb][s] = *(const bf16x8*)(LW + ((size_t)((wid * 2 + mat) * 64 + nb * 32 + r)) * 64 + 16 * s + 8 * hh);
    float ba[2], bx[2], c8[2];
#pragma unroll
    for (int nb = 0; nb < 2; ++nb) { const int ch = 64 * wid + 32 * nb + r; ba[nb] = P.in(12)[l * LRUW + ch]; bx[nb] = P.in(14)[l * LRUW + ch];
        c8[nb] = -8.0f * log1pf(expf(-P.in(15)[l * LRUW + ch])); }
    const float cw0 = P.in(9)[(l * 4 + 0) * LRUW + tid], cw1 = P.in(9)[(l * 4 + 1) * LRUW + tid], cw2 = P.in(9)[(l * 4 + 2) * LRUW + tid], cw3 = P.in(9)[(l * 4 + 3) * LRUW + tid];
    const float cbias = P.in(10)[l * LRUW + tid];
    for (int unit = P.bx; unit < NB * NCH; unit += P.G) {
        const int b = unit / NCH, c = unit - b * NCH, t0 = 32 * c;
        {
            const bf16_t* zr = Z + (size_t)(b * T + t0) * LDZ + tid;
            float xm3 = 0.f, xm2 = 0.f, xm1 = 0.f;
            if (t0 > 0) { xm3 = bf2f(zr[-3 * LDZ]); xm2 = bf2f(zr[-2 * LDZ]); xm1 = bf2f(zr[-1 * LDZ]); }
#pragma unroll 8
            for (int tt = 0; tt < 32; ++tt) {
                const float x = bf2f(zr[(size_t)tt * LDZ]);
                const float xc = cbias + cw3 * x + cw2 * xm1 + cw1 * xm2 + cw0 * xm3;
                xcs[tt * 520 + tid] = f2bf(xc);
                xm3 = xm2; xm2 = xm1; xm1 = x;
            }
        }
        __syncthreads();
        f32x16 accR[2], accI[2];
#pragma unroll
        for (int nb = 0; nb < 2; ++nb) { accR[nb] = f32x16{}; accI[nb] = f32x16{}; }
#pragma unroll
        for (int s = 0; s < 4; ++s) {
            const bf16x8 a = *(const LAS bf16x8*)(xcs + r * 520 + 64 * wid + 16 * s + 8 * hh);
#pragma unroll
            for (int nb = 0; nb < 2; ++nb) {
                accR[nb] = __builtin_amdgcn_mfma_f32_32x32x16_bf16(a, wf[0][nb][s], accR[nb], 0, 0, 0);
                accI[nb] = __builtin_amdgcn_mfma_f32_32x32x16_bf16(a, wf[1][nb][s], accI[nb], 0, 0, 0);
            }
        }
#pragma unroll
        for (int nb = 0; nb < 2; ++nb) {
            const int ch = 64 * wid + 32 * nb + r;
            float av[16], bv[16];
#pragma unroll
            for (int i = 0; i < 16; ++i) {
                const float rg = sigmoidf_(accR[nb][i] + ba[nb]);
                const float ig = sigmoidf_(accI[nb][i] + bx[nb]);
                const float la = c8[nb] * rg;
                const float a = __expf(la);
                const float xc = bf2f(xcs[crow(i, hh) * 520 + ch]);
                av[i] = a; bv[i] = __builtin_amdgcn_sqrtf(fmaxf(__builtin_fmaf(-a, a, 1.0f), 0.f)) * (ig * xc);
            }
            float cin = 0.f, pin = 1.f, hcur = 0.f, pcur = 1.f;
            float ho[16], po[16];
#pragma unroll
            for (int g = 0; g < 4; ++g) {
                hcur = cin; pcur = pin;
#pragma unroll
                for (int e = 0; e < 4; ++e) { hcur = av[4 * g + e] * hcur + bv[4 * g + e]; pcur *= av[4 * g + e]; if (hh == 0) { ho[4 * g + e] = hcur; po[4 * g + e] = pcur; } }
                { const float hx = other_x32(hcur, hh), px = other_x32(pcur, hh); if (hh == 1) { cin = hx; pin = px; } }
                hcur = cin; pcur = pin;
#pragma unroll
                for (int e = 0; e < 4; ++e) { hcur = av[4 * g + e] * hcur + bv[4 * g + e]; pcur *= av[4 * g + e]; if (hh == 1) { ho[4 * g + e] = hcur; po[4 * g + e] = pcur; } }
                { const float hx = other_x32(hcur, hh), px = other_x32(pcur, hh); if (hh == 0) { cin = hx; pin = px; } }
            }
            if (hh == 1) { AAGG[(size_t)(b * NCH + c) * LRUW + ch] = pcur; BAGG[(size_t)(b * NCH + c) * LRUW + ch] = hcur; }
#pragma unroll
            for (int i = 0; i < 16; ++i) {
                const int t = t0 + crow(i, hh);
                if (t < T) { const size_t o = (size_t)(b * T + t) * LRUW + ch; HLOC[o] = f2bf(ho[i]); PA[o] = f2bf(po[i]); }
            }
        }
        __syncthreads();
    }
}

DI void lru_final(const Params& P0, int l, LAS unsigned char* lds) {
    const PV P = MKPV(P0);
    const int tid = P.tid;
    const bf16_t* Z = (const bf16_t*)(P.ws() + WS_Z);
    const bf16_t* HLOC = (const bf16_t*)((unsigned char*)P.out() + DO_HLOC); const bf16_t* PA = (const bf16_t*)((unsigned char*)P.out() + DO_PA);
    const float* AAGG = (const float*)(P.ws() + WS_AAGG); const float* BAGG = (const float*)(P.ws() + WS_BAGG);
    bf16_t* AOUT = (bf16_t*)(P.ws() + WS_AOUT);
    LAS float* carry = (LAS float*)lds;
    const int tok = tid >> 4, cg16 = tid & 15;
    const int nun = NB * NCH, base = nun / P.G, rem = nun - base * P.G;
    const int u0 = P.bx * base + (P.bx < rem ? P.bx : rem), u1 = u0 + base + (P.bx < rem ? 1 : 0);
    if (u0 >= u1) return;
    f32x4 gg[8];
    { const f32x4* gp = (const f32x4*)(P.in(20) + l * LRUW + cg16 * 32);
#pragma unroll
      for (int q = 0; q < 8; ++q) gg[q] = gp[q]; }
    u32x4 hw[4], pw[4], gw[4]; float an = 0.f, bn = 0.f;
#define LF_LOAD(U, H_, P_, G_, A_, B_) do { const int b_ = (U) / NCH, c_ = (U) - b_ * NCH, t_ = 32 * c_ + tok; \
        A_ = AAGG[(size_t)(b_ * NCH + c_) * LRUW + tid]; B_ = BAGG[(size_t)(b_ * NCH + c_) * LRUW + tid]; \
        if (t_ < T) { const size_t row_ = (size_t)b_ * T + t_; \
            const u32x4* hp_ = (const u32x4*)(HLOC + row_ * LRUW + cg16 * 32); const u32x4* pp_ = (const u32x4*)(PA + row_ * LRUW + cg16 * 32); const u32x4* gp_ = (const u32x4*)(Z + row_ * LDZ + 512 + cg16 * 32); \
            _Pragma("unroll") for (int q = 0; q < 4; ++q) { H_[q] = hp_[q]; P_[q] = pp_[q]; G_[q] = gp_[q]; } } } while (0)
    LF_LOAD(u0, hw, pw, gw, an, bn);
    float cr = 0.f;
    {
        const int b = u0 / NCH, c = u0 - b * NCH;
        const float* ap = AAGG + (size_t)b * NCH * LRUW + tid; const float* bp = BAGG + (size_t)b * NCH * LRUW + tid;
        int j = 0;
        for (; j + 16 <= c; j += 16) {
            float aa[16], bb[16];
#pragma unroll
            for (int k = 0; k < 16; ++k) { aa[k] = ap[(size_t)(j + k) * LRUW]; bb[k] = bp[(size_t)(j + k) * LRUW]; }
#pragma unroll
            for (int k = 0; k < 16; ++k) cr = aa[k] * cr + bb[k];
        }
        for (; j < c; ++j) cr = ap[(size_t)j * LRUW] * cr + bp[(size_t)j * LRUW];
    }
    for (int unit = u0; unit < u1; ++unit) {
        const int b = unit / NCH, c = unit - b * NCH, t0 = 32 * c;
        carry[(tid >> 5) * 33 + (tid & 31)] = cr;
        __syncthreads();
        u32x4 hn[4], pn[4], gn[4]; float an2 = 0.f, bn2 = 0.f;
#pragma unroll
        for (int q = 0; q < 4; ++q) { hn[q] = hw[q]; pn[q] = pw[q]; gn[q] = gw[q]; }
        if (unit + 1 < u1) LF_LOAD(unit + 1, hn, pn, gn, an2, bn2);
        const int t = t0 + tok;
        if (t < T) {
            const size_t row = (size_t)b * T + t;
            float y[32]; float ss = 0.f;
#pragma unroll
            for (int q = 0; q < 4; ++q) {
                const unsigned hws[4] = {hw[q].x, hw[q].y, hw[q].z, hw[q].w}, pws[4] = {pw[q].x, pw[q].y, pw[q].z, pw[q].w}, gws[4] = {gw[q].x, gw[q].y, gw[q].z, gw[q].w};
#pragma unroll
                for (int k = 0; k < 4; ++k) {
                    const int e = q * 8 + 2 * k;
                    const float c0 = carry[cg16 * 33 + e], c1 = carry[cg16 * 33 + e + 1];
                    const float y0 = (bflo(hws[k]) + bflo(pws[k]) * c0) * gelu_tanh(bflo(gws[k]));
                    const float y1 = (bfhi(hws[k]) + bfhi(pws[k]) * c1) * gelu_tanh(bfhi(gws[k]));
                    y[e] = y0; y[e + 1] = y1; ss += y0 * y0 + y1 * y1;
                }
            }
            ss += sx<1>(ss); ss += sx<2>(ss); ss += sx<4>(ss); ss += sx<8>(ss);
            const float rn = rsqrtf(ss * (1.0f / LRUW) + EPS);
            u32x4* op = (u32x4*)(AOUT + row * D + 512 + cg16 * 32);
#pragma unroll
            for (int q = 0; q < 4; ++q) {
                const f32x4 ga = gg[2 * q], gb = gg[2 * q + 1];
                u32x4 w;
                w.x = cvt_pk(y[8 * q + 0] * rn * ga[0], y[8 * q + 1] * rn * ga[1]);
                w.y = cvt_pk(y[8 * q + 2] * rn * ga[2], y[8 * q + 3] * rn * ga[3]);
                w.z = cvt_pk(y[8 * q + 4] * rn * gb[0], y[8 * q + 5] * rn * gb[1]);
                w.w = cvt_pk(y[8 * q + 6] * rn * gb[2], y[8 * q + 7] * rn * gb[3]);
                op[q] = w;
            }
        }
        __syncthreads();
        cr = (c + 1 == NCH) ? 0.f : an * cr + bn;
#pragma unroll
        for (int q = 0; q < 4; ++q) { hw[q] = hn[q]; pw[q] = pn[q]; gw[q] = gn[q]; }
        an = an2; bn = bn2;
    }
#undef LF_LOAD
}

constexpr int AK_ROW = 208, AV_ROW = 144, AK_BYTES = 64 * AK_ROW, AV_BYTES = 64 * AV_ROW;
constexpr int APAIR = 2 * AK_BYTES + 2 * AV_BYTES;
DI void qk_tile(f32x16& p0, f32x16& p1, const LAS unsigned char* Kb, const bf16x8 (&qf)[6], const f32x16& negm, int r, int hh) {
    bf16x8 kf[12];
#pragma unroll
    for (int s = 0; s < 6; ++s) {
        kf[2 * s] = *(const LAS bf16x8*)(Kb + r * AK_ROW + (16 * s + 8 * hh) * 2);
        kf[2 * s + 1] = *(const LAS bf16x8*)(Kb + (32 + r) * AK_ROW + (16 * s + 8 * hh) * 2);
    }
    p0 = __builtin_amdgcn_mfma_f32_32x32x16_bf16(kf[0], qf[0], negm, 0, 0, 0);
    p1 = __builtin_amdgcn_mfma_f32_32x32x16_bf16(kf[1], qf[0], negm, 0, 0, 0);
#pragma unroll
    for (int s = 1; s < 6; ++s) {
        p0 = __builtin_amdgcn_mfma_f32_32x32x16_bf16(kf[2 * s], qf[s], p0, 0, 0, 0);
        p1 = __builtin_amdgcn_mfma_f32_32x32x16_bf16(kf[2 * s + 1], qf[s], p1, 0, 0, 0);
    }
}
DI void pv_tile(f32x16 (&o)[2], const LAS unsigned char* Vb, const f32x16& p0, const f32x16& p1, int r, int hh) {
    bf16x8 vf[8];
#pragma unroll
    for (int db = 0; db < 2; ++db)
#pragma unroll
        for (int s = 0; s < 4; ++s) vf[db * 4 + s] = *(const LAS bf16x8*)(Vb + (32 * db + r) * AV_ROW + (16 * s + 8 * hh) * 2);
    bf16x8 pw[4];
#pragma unroll
    for (int s = 0; s < 2; ++s) {
        u32x4 w0, w1;
        w0.x = cvt_pk(p0[8 * s + 0], p0[8 * s + 1]); w0.y = cvt_pk(p0[8 * s + 2], p0[8 * s + 3]); w0.z = cvt_pk(p0[8 * s + 4], p0[8 * s + 5]); w0.w = cvt_pk(p0[8 * s + 6], p0[8 * s + 7]);
        w1.x = cvt_pk(p1[8 * s + 0], p1[8 * s + 1]); w1.y = cvt_pk(p1[8 * s + 2], p1[8 * s + 3]); w1.z = cvt_pk(p1[8 * s + 4], p1[8 * s + 5]); w1.w = cvt_pk(p1[8 * s + 6], p1[8 * s + 7]);
        pw[s] = __builtin_bit_cast(bf16x8, w0); pw[2 + s] = __builtin_bit_cast(bf16x8, w1);
    }
#pragma unroll
    for (int db = 0; db < 2; ++db)
#pragma unroll
        for (int s = 0; s < 4; ++s) o[db] = __builtin_amdgcn_mfma_f32_32x32x16_bf16(vf[db * 4 + s], pw[s], o[db], 0, 0, 0);
}
DI float vmax16(const f32x16& a, const f32x16& b) {
    float m = __builtin_elementwise_maximum(a[0], b[0]);
#pragma unroll
    for (int i = 1; i < 16; ++i) m = __builtin_elementwise_maximum(__builtin_elementwise_maximum(m, a[i]), b[i]);
    return m;
}
constexpr float ATT_THR = 6.0f;
#define ATT_RESCALE(first, rm, SHIFT_STMT) do { \
        if ((first) || __any((rm) > ATT_THR)) { \
            const float dl = (first) ? (rm) : __builtin_elementwise_maximum((rm), 0.f); \
            mhat += dl; SHIFT_STMT; \
            const float f_ = __builtin_amdgcn_exp2f(-dl); lsum *= f_; \
            _Pragma("unroll") for (int i = 0; i < 16; ++i) { o[0][i] *= f_; o[1][i] *= f_; } \
            _Pragma("unroll") for (int i = 0; i < 16; ++i) negm[i] = -mhat; \
        } } while (0)
DI void attn_tile1(f32x16 (&o)[2], float& mhat, float& lsum, f32x16& negm, bool first, const LAS unsigned char* Kb, const LAS unsigned char* Vb, const bf16x8 (&qf)[6], int kv0, int qmin, int qrow, int r, int hh) {
    f32x16 p0, p1;
    qk_tile(p0, p1, Kb, qf, negm, r, hh);
    if (kv0 + 63 > qmin) {
#pragma unroll
        for (int i = 0; i < 16; ++i) { const int kv = kv0 + crow(i, hh); if (kv > qrow) p0[i] = -INFINITY; if (kv + 32 > qrow) p1[i] = -INFINITY; }
    }
    const float rm = max_x32(vmax16(p0, p1));
    ATT_RESCALE(first, rm, { _Pragma("unroll") for (int i = 0; i < 16; ++i) { p0[i] -= dl; p1[i] -= dl; } });
    float ps = 0.f;
#pragma unroll
    for (int i = 0; i < 16; ++i) { p0[i] = __builtin_amdgcn_exp2f(p0[i]); p1[i] = __builtin_amdgcn_exp2f(p1[i]); ps += p0[i] + p1[i]; }
    lsum += ps;
    pv_tile(o, Vb, p0, p1, r, hh);
}
DI void attn_tile2(f32x16 (&o)[2], float& mhat, float& lsum, f32x16& negm, bool first, const LAS unsigned char* KbA, const LAS unsigned char* VbA, const LAS unsigned char* KbB, const LAS unsigned char* VbB,
                   const bf16x8 (&qf)[6], int r, int hh) {
    f32x16 a0, a1, b0, b1;
    qk_tile(a0, a1, KbA, qf, negm, r, hh);
    qk_tile(b0, b1, KbB, qf, negm, r, hh);
    const float rm = max_x32(__builtin_elementwise_maximum(vmax16(a0, a1), vmax16(b0, b1)));
    ATT_RESCALE(first, rm, { _Pragma("unroll") for (int i = 0; i < 16; ++i) { a0[i] -= dl; a1[i] -= dl; b0[i] -= dl; b1[i] -= dl; } });
    float ps = 0.f, qs = 0.f;
#pragma unroll
    for (int i = 0; i < 16; ++i) { a0[i] = __builtin_amdgcn_exp2f(a0[i]); a1[i] = __builtin_amdgcn_exp2f(a1[i]); ps += a0[i] + a1[i]; }
    pv_tile(o, VbA, a0, a1, r, hh);
#pragma unroll
    for (int i = 0; i < 16; ++i) { b0[i] = __builtin_amdgcn_exp2f(b0[i]); b1[i] = __builtin_amdgcn_exp2f(b1[i]); qs += b0[i] + b1[i]; }
    lsum += ps + qs;
    pv_tile(o, VbB, b0, b1, r, hh);
}
DI void attn_unit(const PV& P, LAS unsigned char* lds, int bh, int q0, int nq) {
    const int tid = P.tid, lane = tid & 63, wid = __builtin_amdgcn_readfirstlane(tid >> 6), r = lane & 31, hh = lane >> 5;
    const bf16_t* Qg = (const bf16_t*)(P.ws() + WS_Q); const bf16_t* Kg = (const bf16_t*)(P.ws() + WS_K); const bf16_t* Vg = (const bf16_t*)(P.ws() + WS_VT);
    bf16_t* AOUT = (bf16_t*)(P.ws() + WS_AOUT); float* ssqm = (float*)(P.ws() + WS_SSQM);
    const int b = bh >> 3, hd = bh & 7;
    const int NT = (q0 + nq - 1) / 64 + 1;
    const bool active = (32 * wid) < nq;
    const int qmin = q0 + 32 * wid, qmax = qmin + 31, qrow = qmin + r;
    bf16x8 qf[6];
    {
        const bf16_t* qp = Qg + ((size_t)bh * TP + qrow) * DQK + 8 * hh;
#pragma unroll
        for (int s = 0; s < 6; ++s) qf[s] = *(const bf16x8*)(qp + 16 * s);
    }
    const unsigned char* kbase = (const unsigned char*)(Kg + (size_t)bh * TP * DQK);
    const unsigned char* vbase = (const unsigned char*)(Vg + (size_t)bh * DV * TP);
    unsigned koff[2], voff[2];
#pragma unroll
    for (int i = 0; i < 2; ++i) {
        const int pk = (wid + 8 * i) * 64 + lane, rk = pk / 13, ck = pk - rk * 13;
        koff[i] = (unsigned)((rk * 12 + (ck < 12 ? ck : 0)) * 16);
        const int pv = (wid + 8 * i) * 64 + lane, rv = pv / 9, cv = pv - rv * 9;
        voff[i] = (unsigned)((rv * TP + (cv < 8 ? cv : 0) * 8) * 2);
    }
#define ATT_DMA(t, buf, slot) do { const unsigned char* kt_ = kbase + (size_t)(t) * (64 * DQK * 2); const unsigned char* vt_ = vbase + (size_t)(t) * 128; \
        LAS unsigned char* kb_ = lds + (buf) * APAIR + (slot) * AK_BYTES; LAS unsigned char* vb_ = lds + (buf) * APAIR + 2 * AK_BYTES + (slot) * AV_BYTES; \
        __builtin_amdgcn_global_load_lds((const unsigned*)(kt_ + koff[0]), (LAS unsigned*)(kb_ + wid * 1024), 16, 0, 0); \
        if (wid < 5) __builtin_amdgcn_global_load_lds((const unsigned*)(kt_ + koff[1]), (LAS unsigned*)(kb_ + (wid + 8) * 1024), 16, 0, 0); \
        __builtin_amdgcn_global_load_lds((const unsigned*)(vt_ + voff[0]), (LAS unsigned*)(vb_ + wid * 1024), 16, 0, 0); \
        if (wid < 1) __builtin_amdgcn_global_load_lds((const unsigned*)(vt_ + voff[1]), (LAS unsigned*)(vb_ + (wid + 8) * 1024), 16, 0, 0); } while (0)
    ATT_DMA(0, 0, 0); if (NT > 1) ATT_DMA(1, 0, 1);
    asm volatile("s_waitcnt vmcnt(0)" ::: "memory");
    __syncthreads();
    f32x16 o[2]; o[0] = f32x16{}; o[1] = f32x16{};
    float mhat = 0.f, lsum = 0.f;
    f32x16 negm = f32x16{};
    for (int j = 0; j < NT; j += 2) {
        const int cur = (j >> 1) & 1;
        if (j + 2 < NT) ATT_DMA(j + 2, cur ^ 1, 0);
        if (j + 3 < NT) ATT_DMA(j + 3, cur ^ 1, 1);
        const LAS unsigned char* KbA = lds + cur * APAIR; const LAS unsigned char* KbB = KbA + AK_BYTES;
        const LAS unsigned char* VbA = KbA + 2 * AK_BYTES; const LAS unsigned char* VbB = VbA + AV_BYTES;
        const bool doA = active && (64 * j <= qmax);
        const bool doB = active && (j + 1 < NT) && (64 * (j + 1) <= qmax);
        if (doB && (64 * (j + 1) + 63 <= qmin)) {
            attn_tile2(o, mhat, lsum, negm, j == 0, KbA, VbA, KbB, VbB, qf, r, hh);
        } else {
            if (doA) attn_tile1(o, mhat, lsum, negm, j == 0, KbA, VbA, qf, 64 * j, qmin, qrow, r, hh);
            if (doB) attn_tile1(o, mhat, lsum, negm, false, KbB, VbB, qf, 64 * (j + 1), qmin, qrow, r, hh);
        }
        asm volatile("s_waitcnt vmcnt(0)" ::: "memory");
        __syncthreads();
    }
#undef ATT_DMA
    if (active) {
        const float ltot = sum_x32(lsum);
        const float inv = 1.0f / ltot;
        float ss = 0.f;
#pragma unroll
        for (int db = 0; db < 2; ++db)
#pragma unroll
            for (int i = 0; i < 16; ++i) { o[db][i] *= inv; ss += o[db][i] * o[db][i]; }
        ss = sum_x32(ss);
        if (32 * wid + r < nq) {
            const size_t row = (size_t)b * T + qrow;
            bf16_t* dst = AOUT + row * D + hd * DV;
#pragma unroll
            for (int db = 0; db < 2; ++db)
#pragma unroll
                for (int g4 = 0; g4 < 4; ++g4) {
                    u32x2 w; w.x = cvt_pk(o[db][4 * g4 + 0], o[db][4 * g4 + 1]); w.y = cvt_pk(o[db][4 * g4 + 2], o[db][4 * g4 + 3]);
                    *(u32x2*)(dst + 32 * db + 8 * g4 + 4 * hh) = w;
                }
            if (hh == 0) ssqm[row * 8 + hd] = ss;
        }
    }
}
DI void attn_phase(const Params& P0, LAS unsigned char* lds) {
    const PV P = MKPV(P0);
    const int vcu = ((P.G & 7) == 0) ? ((P.bx & 7) * (P.G >> 3) + (P.bx >> 3)) : P.bx;
    for (int w = vcu; w < 64 * 8; w += P.G) {
        const int bh = w >> 3, p = w & 7;
        attn_unit(P, lds, bh, 16 + 256 * (15 - p), 256);
        attn_unit(P, lds, bh, 16 + 256 * p, 256);
    }
    for (int w = P.bx; w < 64; w += P.G) attn_unit(P, lds, w, 0, 16);
}


#define XB_TMO      128
#define XB_XCNT(j)  (256  + 64 * (j))
#define XB_XSUB(j)  (1280 + 64 * (j))
#define XB_XGEN(j)  (2304 + 64 * (j))
#define XB_TOP      3328
#define XB_TOPGEN   3392
#define XCD_BAR_WORDS 3456
#define XB_SPIN_CAP (1u << 18)
DI unsigned xb_ld(unsigned* p)              { return __hip_atomic_load(p, __ATOMIC_RELAXED, __HIP_MEMORY_SCOPE_AGENT); }
DI unsigned xb_add(unsigned* p, unsigned v) { return __hip_atomic_fetch_add(p, v, __ATOMIC_RELAXED, __HIP_MEMORY_SCOPE_AGENT); }
DI unsigned xb_xcc_id() { return (unsigned)__builtin_amdgcn_s_getreg((3 << 11) | 20) & 0xFu; }
#define XB_SPIN(cond, bar) do { unsigned _sp = 0; while (cond) { __builtin_amdgcn_s_sleep(1); \
    if ((++_sp & 255u) == 0u) { if (xb_ld(&(bar)[XB_TMO])) break; if (_sp > XB_SPIN_CAP) { atomicAdd(&(bar)[XB_TMO], 1u); break; } } } } while (0)
struct XcdBarrier { unsigned* bar; unsigned x; volatile LAS unsigned* st; };
DI void xcd_barrier_post(unsigned* bar) { if (threadIdx.x == 0) (void)xb_add(&bar[XB_XCNT(xb_xcc_id())], 1u); }
DI void xcd_barrier_complete(unsigned* bar, unsigned x, unsigned& nloc, unsigned& nx) {
    const unsigned G = gridDim.x * gridDim.y * gridDim.z;
    unsigned sum, cnt, mine, sp = 0u;
    for (;;) {
        sum = 0u; cnt = 0u; mine = 0u;
#pragma unroll
        for (unsigned j = 0; j < 16; ++j) { const unsigned c = xb_ld(&bar[XB_XCNT(j)]); sum += c; cnt += (c > 0u) ? 1u : 0u; mine = (j == x) ? c : mine; }
        if (sum == G) break;
        __builtin_amdgcn_s_sleep(1);
        if ((++sp & 255u) == 0u) { if (xb_ld(&bar[XB_TMO])) break; if (sp > XB_SPIN_CAP) { atomicAdd(&bar[XB_TMO], 1u); break; } }
    }
    nloc = mine > 0u ? mine : 1u; nx = cnt > 0u ? cnt : 1u;
}
DI void xcd_barrier(const XcdBarrier& b) {
    asm volatile("s_waitcnt vmcnt(0)" ::: "memory");
    __syncthreads();
    if (threadIdx.x == 0) {
        unsigned* bar = b.bar;
        __builtin_amdgcn_s_waitcnt(0);
        unsigned nloc = b.st[0], nx = b.st[1];
        if (nloc == 0u) { xcd_barrier_complete(bar, b.x, nloc, nx); b.st[0] = nloc; b.st[1] = nx; }
        const unsigned old = xb_add(&bar[XB_XSUB(b.x)], 1u);
        const unsigned gen = old / nloc;
        if (old + 1u == (gen + 1u) * nloc) {
            __builtin_amdgcn_fence(__ATOMIC_RELEASE, "agent");
            asm volatile("s_waitcnt vmcnt(0)" ::: "memory");
            const unsigned og = xb_add(&bar[XB_TOP], 1u);
            const unsigned tg = og / nx;
            if (og + 1u == (tg + 1u) * nx) xb_add(&bar[XB_TOPGEN], 1u);
            else XB_SPIN(xb_ld(&bar[XB_TOPGEN]) == tg, bar);
            __builtin_amdgcn_fence(__ATOMIC_ACQUIRE, "agent");
            xb_add(&bar[XB_XGEN(b.x)], 1u);
            asm volatile("s_waitcnt vmcnt(0)" ::: "memory");
        } else {
            XB_SPIN(xb_ld(&bar[XB_XGEN(b.x)]) == gen, bar);
            __builtin_amdgcn_fence(__ATOMIC_ACQUIRE, "agent");
            asm volatile("s_waitcnt vmcnt(0)" ::: "memory");
        }
    }
    __syncthreads();
}

#ifndef PHMASK
#define PHMASK 0xfff
#endif
#define PHON(k) ((PHMASK >> (k)) & 1)
#ifndef REPMASK
#define REPMASK 0
#endif
__global__ void __launch_bounds__(512, 2) mega_fwd(Params P) {
    extern __shared__ __attribute__((aligned(16))) unsigned char lds_raw[];
    LAS unsigned char* lds = (LAS unsigned char*)lds_raw;
    cg::grid_group grid = cg::this_grid();
    volatile LAS unsigned* bst = (volatile LAS unsigned*)(lds + 131072 + 64);
    if (threadIdx.x < 2) bst[threadIdx.x] = 0u;
    __syncthreads();
    xcd_barrier_post((unsigned*)(launder_g(P.ws) + WS_BAR));
    int rep = 0;
    for (int ph = P.ph_lo; ph < P.ph_hi; ++ph) {
        const PV V = mkpv(P);
        unsigned char* ws = V.wsp;
        const int G = V.G, bx = V.bx;
        if (ph == 0) {
          if (PHON(11)) {
            row_pass<0>(P, 0, 0, 0.f, 0, 0, false);
            {
                float* cosT = (float*)(ws + WS_COS); float* sinT = (float*)(ws + WS_SIN);
                for (int i = bx * 512 + opq_tid(); i < T * 16; i += G * 512) {
                    const int t = i >> 4, k = i & 15;
                    const float inv = 1.0f / powf(10000.0f, (float)(2 * k) / 32.0f);
                    const float ang = (float)t * inv;
                    cosT[i] = cosf(ang); sinT[i] = sinf(ang);
                }
            }
            wprep_layer(P, 0, lds);
          }
        } else {
            const int l = (ph - 1) / 11, s = (ph - 1) % 11;
            const unsigned char* wb = ws + WS_W;
            if (s == 0 || s == 8) {
              if (PHON(0)) {
                pg8::Gemm g{(const bf16_t*)(ws + WS_HB), (const bf16_t*)(wb + (s == 0 ? WO_GU1 : WO_GU2)), MP, NGU, D, D, D, 0};
                pg8::StaticOrder S; S.init(MP, NGU, G, bx);
                EpiGU E{ws};
                pg8::gemm_phase(lds, g, S, E);
              }
            } else if (s == 1 || s == 9) {
              if (PHON(1)) {
                {
                    pg8::Gemm g{(const bf16_t*)(ws + WS_ACT), (const bf16_t*)(wb + (s == 1 ? WO_D1 : WO_D2)), 32768, D, DFF, DFF, DFF, 0};
                    pg8::StaticOrder S; S.init(32768, D, G, bx);
                    EpiStore<false> E{ws};
                    pg8::gemm_phase(lds, g, S, E);
                }
                for (int ck = 0; ck < 11; ++ck) {
                    pg8::Gemm g{(const bf16_t*)(ws + WS_ACT) + (size_t)32768 * DFF + ck * 256, (const bf16_t*)(wb + (s == 1 ? WO_D1 : WO_D2)) + ck * 256, 256, D, 256, DFF, DFF, 32768};
                    pg8::StaticOrder S; S.init(256, D, G, (bx - 4 * ck + G) % G);
                    EpiPart E{ws, (float*)(ws + WS_PARTD) + (size_t)ck * 128 * D, 0};
                    pg8::gemm_phase(lds, g, S, E);
                }
              }
            } else if (s == 2) {
              if (PHON(2)) row_pass<1>(P, 6, l, 0.5f, WS_PARTD, 11, false);
            } else if (s == 3) {
              if (PHON(3)) {
                pg8::Gemm g{(const bf16_t*)(ws + WS_HB), (const bf16_t*)(wb + WO_IN), MP, NIN, D, D, D, 0};
                pg8::StaticOrder S; S.init(MP, NIN, G, bx);
                EpiIn E{ws, (unsigned char*)V.outp};
                pg8::gemm_phase(lds, g, S, E);
              }
            } else if (s == 4) {
              if (PHON(4)) {
                {
                    bf16_t* Vt = (bf16_t*)(ws + WS_VT);
                    const unsigned zu = (unsigned)opq_s();
                    for (int i = bx * 512 + opq_tid(); i < 64 * 64 * 6; i += G * 512) { const int rw = i / 6, cc = i - rw * 6; *(u32x4*)(Vt + (size_t)rw * TP + T + cc * 8) = (u32x4){zu, zu, zu, zu}; }
                }
                lru_local(P, l, lds);
              }
              if (PHON(5)) {
                {
                    pg8::Gemm g{(const bf16_t*)(ws + WS_Z) + 1024, (const bf16_t*)(wb + WO_UQ), MP, NQ, QL, LDZ, QL, 0};
                    pg8::StaticOrder S; S.init(MP, NQ, G, bx);
                    EpiQ E{ws};
                    pg8::gemm_phase(lds, g, S, E);
                }
              }
              if (PHON(6)) {
                {
                    pg8::Gemm g{(const bf16_t*)(ws + WS_Z) + 1408, (const bf16_t*)(wb + WO_UKV), MP, NKV, KVL, LDZ, KVL, 0};
                    pg8::StaticOrder S; S.init(MP, NKV, G, (G - 1) - bx);
                    EpiKV E{ws, (unsigned char*)V.outp};
                    pg8::gemm_phase(lds, g, S, E);
                }
              }
            } else if (s == 5) {
                if (PHON(7)) lru_final(P, l, lds);
                if (PHON(8)) attn_phase(P, lds);
            } else if (s == 6) {
              if (PHON(9)) {
                {
                    pg8::Gemm g{(const bf16_t*)(ws + WS_AOUT), (const bf16_t*)(wb + WO_OUT), 32768, D, D, D, D, 0};
                    pg8::StaticOrder S; S.init(32768, D, G, bx);
                    EpiStore<true> E{ws};
                    pg8::gemm_phase(lds, g, S, E);
                }
                for (int ck = 0; ck < 4; ++ck) {
                    pg8::Gemm g{(const bf16_t*)(ws + WS_AOUT) + (size_t)32768 * D + ck * 256, (const bf16_t*)(wb + WO_OUT) + ck * 256, 256, D, 256, D, D, 32768};
                    pg8::StaticOrder S; S.init(256, D, G, (bx - 4 * ck + G) % G);
                    EpiPart E{ws, (float*)(ws + WS_PARTO) + (size_t)ck * 128 * D, ck < 2 ? 1 : 0};
                    pg8::gemm_phase(lds, g, S, E);
                }
              }
            } else if (s == 7) {
              if (PHON(2)) row_pass<1>(P, 23, l, 1.0f, WS_PARTO, 4, false);
            } else {
              if (PHON(2)) row_pass<1>(P, 28, l, 0.5f, WS_PARTD, 11, l == DEPTH - 1);
              if (PHON(10)) { if (l + 1 < DEPTH) wprep_layer(P, l + 1, lds); }
            }
        }
        if (ph + 1 < P.ph_hi) {
            if (P.ph_lo < 0) grid.sync();
            { XcdBarrier xb{(unsigned*)(V.wsp + WS_BAR), xb_xcc_id(), bst}; xcd_barrier(xb); }
        }
        if (REPMASK != 0 && ph > 0 && rep == 0 && ((REPMASK >> ((ph - 1) % 11)) & 1)) { rep = 1; --ph; } else rep = 0;
    }
}

extern "C" void kernel_launch(void* const* d_in, const int* in_sizes, int n_in, void* d_out, int out_size, void* d_ws, size_t ws_size, hipStream_t stream) {
    static int grid = 0;
    if (grid == 0) {
        if (n_in != 29 || ws_size < WS_END || out_size != NB * SEQ * D) { fprintf(stderr, "kernel_launch: unexpected problem (n_in %d, ws %zu, out %d)\n", n_in, ws_size, out_size); grid = -1; return; }
        int dev = 0, cus = 0, per_cu = 0;
        hipGetDevice(&dev);
        hipDeviceGetAttribute(&cus, hipDeviceAttributeMultiprocessorCount, dev);
        hipFuncSetAttribute((const void*)mega_fwd, hipFuncAttributeMaxDynamicSharedMemorySize, LDS_BYTES);
        hipOccupancyMaxActiveBlocksPerMultiprocessor(&per_cu, (const void*)mega_fwd, 512, LDS_BYTES);
        if (per_cu < 1) { fprintf(stderr, "kernel_launch: occupancy query says %d blocks per CU\n", per_cu); per_cu = 1; }
        grid = cus * 1;
        (void)hipGetLastError();
    }
    if (grid < 0) return;
    (void)hipMemsetAsync((unsigned char*)d_ws + WS_BAR, 0, XCD_BAR_WORDS * 4, stream);
    Params p{};
    for (int i = 0; i < 29; ++i) p.in[i] = (const float*)d_in[i];
    p.out = (float*)d_out; p.ws = (unsigned char*)d_ws; p.ph_lo = 0; p.ph_hi = 1 + 11 * DEPTH;
    void* args[] = {&p};
    hipError_t e = hipLaunchCooperativeKernel((const void*)mega_fwd, dim3(grid), dim3(512), args, LDS_BYTES, stream);
    if (e != hipSuccess) fprintf(stderr, "cooperative launch failed: %s (grid %d)\n", hipGetErrorString(e), grid);
}
```
